# Optimizing an MI355X kernel written in HIP

```python
import jax, jax.numpy as jnp
from jax import lax
import numpy as np

D_MODEL = 1024
BATCH = 4
SEQ = 8192
DEPTH = 2
DEC_BATCH = 8
DEC_SEQ = 64
PAST_LEN = 2048

CHUNK = 64
N_HEADS = 8
HEAD_DIM = 64
KV_HEADS = 2
GROUPS = N_HEADS // KV_HEADS
IDX_HEADS = 4
IDX_DIM = 64
TOPK_MAX = 256
Q_BLOCK = 128
ROPE_THETA = 500000.0
ATTN_SCALE = HEAD_DIM ** -0.5
IDX_SCALE = (IDX_DIM ** -0.5) * (IDX_HEADS ** -0.5)
NEG = -1e30
HGRN_HEADS = 4
HGRN_DK = 128
HGRN_DV = 128
SCONV_WIDTH = 512
CONV_W = 3
BRANCH_WIDTH = 512
N_BRANCH = 3
D_FF = 2816
ALPHA = (2 * DEPTH) ** 0.25
BETA = (8 * DEPTH) ** -0.25
LN_EPS = 1e-5
IN_SIZES = (N_HEADS * HEAD_DIM, KV_HEADS * HEAD_DIM, KV_HEADS * HEAD_DIM,
            IDX_HEADS * IDX_DIM, IDX_DIM, IDX_HEADS,
            HGRN_HEADS * HGRN_DK, HGRN_HEADS * HGRN_DK, HGRN_HEADS * HGRN_DV, HGRN_HEADS * HGRN_DV,
            SCONV_WIDTH, SCONV_WIDTH, SCONV_WIDTH,
            N_BRANCH * D_MODEL)
IN_COLS = sum(IN_SIZES)

kernel_name = "hybrid_dsa_hgrn2_shortconv_stream_step"


def layer_norm(x, g, b):
    xf = x.astype(jnp.float32)
    mu = jnp.mean(xf, axis=-1, keepdims=True)
    var = jnp.mean(jnp.square(xf - mu), axis=-1, keepdims=True)
    return ((xf - mu) * lax.rsqrt(var + LN_EPS) * g + b).astype(x.dtype)


def partial_rotary(x, pos):
    rot = x.shape[-1] // 4
    half = rot // 2
    inv_freq = ROPE_THETA ** (-jnp.arange(half, dtype=jnp.float32) / half)
    ang = pos.astype(jnp.float32)[:, None] * inv_freq[None, :]
    cos = jnp.cos(ang)[:, None, :]
    sin = jnp.sin(ang)[:, None, :]
    x1 = x[..., :half].astype(jnp.float32)
    x2 = x[..., half:rot].astype(jnp.float32)
    return jnp.concatenate([(x1 * cos - x2 * sin).astype(x.dtype),
                            (x2 * cos + x1 * sin).astype(x.dtype),
                            x[..., rot:]], axis=-1)


def causal_dwconv(u, hist, w, b):
    S = u.shape[1]
    up = jnp.concatenate([hist.astype(u.dtype), u], axis=1)
    y = b
    for j in range(CONV_W):
        y = y + w[j] * up[:, j:j + S]
    return y, up[:, S:]


def dsa_attention(q, qi, wi, k_all, v_all, ki_all, q_pos):
    f32 = jnp.float32
    B, S = q.shape[:2]
    L = k_all.shape[1]
    top = min(TOPK_MAX, L // 4)
    qb = min(Q_BLOCK, S)
    nb = S // qb
    key_chunk = jnp.arange(L) // CHUNK
    kif = ki_all.astype(f32)

    def blocks(a):
        return jnp.swapaxes(a.reshape((B, nb, qb) + a.shape[2:]), 0, 1)

    def one_block(args):
        q_blk, qi_blk, wi_blk, qpos = args
        admissible = key_chunk[None, :] <= (qpos // CHUNK)[:, None]
        rel = jax.nn.relu(jnp.einsum('bqhd,bsd->bqhs', qi_blk.astype(f32), kif))
        score = jnp.einsum('bqh,bqhs->bqs', wi_blk.astype(f32), rel) * IDX_SCALE
        score = jnp.where(admissible[None], score, NEG)
        _, idx = lax.top_k(score, top)
        valid = admissible[jnp.arange(qb)[None, :, None], idx]
        k_sel = jax.vmap(lambda kk, ii: kk[ii])(k_all, idx)
        v_sel = jax.vmap(lambda vv, ii: vv[ii])(v_all, idx)
        qg = q_blk.reshape(B, qb, KV_HEADS, GROUPS, HEAD_DIM)
        logits = jnp.einsum('bqhgd,bqnhd->bqhgn', qg, k_sel, preferred_element_type=f32) * ATTN_SCALE
        logits = jnp.where(valid[:, :, None, None, :], logits, NEG)
        p = jax.nn.softmax(logits, axis=-1).astype(v_sel.dtype)
        o = jnp.einsum('bqhgn,bqnhd->bqhgd', p, v_sel)
        return o.reshape(B, qb, N_HEADS * HEAD_DIM)

    out = lax.map(one_block, (blocks(q), blocks(qi), blocks(wi), q_pos.reshape(nb, qb)))
    return jnp.swapaxes(out, 0, 1).reshape(B, S, N_HEADS * HEAD_DIM)


def hgrn2_scan(q, k, v, logf, s0):
    B, S, H = q.shape[:3]
    c = min(CHUNK, S)
    n = S // c
    tri = jnp.tril(jnp.ones((c, c), dtype=bool))[:, :, None]

    def chunks(a):
        return a.reshape(B, n, c, a.shape[2], a.shape[3]).transpose(1, 0, 3, 2, 4)

    def step(state, inp):
        qc, kc, vc, lc = inp
        cum = jnp.cumsum(lc, axis=2)
        diff = cum[:, :, :, None, :] - cum[:, :, None, :, :]
        decay = jnp.where(tri, jnp.exp(jnp.where(tri, diff, 0.0)), 0.0)
        scores = jnp.einsum('bhtd,bhsd,bhtsd->bhts', qc, kc, decay)
        o = (jnp.einsum('bhts,bhsv->bhtv', scores, vc)
             + jnp.einsum('bhtd,bhdv->bhtv', qc * jnp.exp(cum), state))
        last = cum[:, :, -1:, :]
        new_state = (jnp.exp(last[:, :, 0, :, None]) * state
                     + jnp.einsum('bhsd,bhsv->bhdv', kc * jnp.exp(last - cum), vc))
        return new_state, o

    s_fin, o = lax.scan(step, s0, (chunks(q), chunks(k), chunks(v), chunks(logf)))
    return o.transpose(1, 0, 3, 2, 4).reshape(B, S, H, v.shape[3]), s_fin


def trunk_layer(x, pos, k_past, v_past, ki_past, s0, sc_hist, ffn_hist, l, weights):
    (w_in, hgrn_lb_logits, hgrn_norm_g, sconv_w, sconv_b, w_branch, w_out, ln1_g, ln1_b,
     w_up, ffn_conv_w, ffn_conv_b, w_down, ln2_g, ln2_b) = weights
    f32 = jnp.float32
    B, S, _ = x.shape
    proj = x @ w_in[l]
    (a_q, a_k, a_v, i_q, i_k, i_w, h_q, h_f, h_i, h_g, c_b, c_c, c_x, g_pre) = jnp.split(
        proj, np.cumsum(IN_SIZES)[:-1].tolist(), axis=-1)

    q = partial_rotary(a_q.reshape(B, S, N_HEADS, HEAD_DIM), pos)
    k = partial_rotary(a_k.reshape(B, S, KV_HEADS, HEAD_DIM), pos)
    v = a_v.reshape(B, S, KV_HEADS, HEAD_DIM)
    qi = partial_rotary(i_q.reshape(B, S, IDX_HEADS, IDX_DIM), pos)
    ki = partial_rotary(i_k.reshape(B, S, 1, IDX_DIM), pos)[:, :, 0]
    if k_past is None:
        k_all, v_all, ki_all = k, v, ki
    else:
        k_all = jnp.concatenate([k_past.astype(k.dtype), k], axis=1)
        v_all = jnp.concatenate([v_past.astype(v.dtype), v], axis=1)
        ki_all = jnp.concatenate([ki_past.astype(ki.dtype), ki], axis=1)
    y_a = dsa_attention(q, qi, i_w, k_all, v_all, ki_all, pos).astype(x.dtype)

    lbp = jax.nn.softmax(hgrn_lb_logits.astype(f32), axis=0)
    lb = (jnp.cumsum(lbp, axis=0) - lbp[0])[l].reshape(HGRN_HEADS, HGRN_DK)
    f_pre = h_f.reshape(B, S, HGRN_HEADS, HGRN_DK).astype(f32)
    logf = jax.nn.log_sigmoid(f_pre) + jnp.log1p(lb * jnp.exp(-f_pre))
    k_h = (1.0 - lb) * jax.nn.sigmoid(-f_pre)
    q_h = jax.nn.silu(h_q.reshape(B, S, HGRN_HEADS, HGRN_DK).astype(f32))
    v_h = h_i.reshape(B, S, HGRN_HEADS, HGRN_DV).astype(f32)
    o_h, s_new = hgrn2_scan(q_h, k_h, v_h, logf, s0.astype(f32))
    o_h = o_h * lax.rsqrt(jnp.mean(jnp.square(o_h), axis=-1, keepdims=True) + LN_EPS) * hgrn_norm_g[l].astype(f32)
    y_b = (o_h.reshape(B, S, HGRN_HEADS * HGRN_DV) * jax.nn.silu(h_g.astype(f32))).astype(x.dtype)

    u = c_c * c_x
    u_conv, sc_new = causal_dwconv(u, sc_hist, sconv_w[l], sconv_b[l])
    y_c = c_b * u_conv

    gates = jax.nn.sigmoid(g_pre.reshape(B, S, N_BRANCH, D_MODEL).astype(f32)).astype(x.dtype)
    merged = (gates[:, :, 0] * (y_a @ w_branch[l, 0])
              + gates[:, :, 1] * (y_b @ w_branch[l, 1])
              + gates[:, :, 2] * (y_c @ w_branch[l, 2]))
    x = layer_norm(ALPHA * x + merged @ w_out[l], ln1_g[l], ln1_b[l])

    h = x @ w_up[l]
    h_conv, ffn_new = causal_dwconv(h, ffn_hist, ffn_conv_w[l], ffn_conv_b[l])
    a_g, b_v = jnp.split(h_conv, 2, axis=-1)
    ffn = (jax.nn.silu(a_g) * b_v) @ w_down[l]
    x = layer_norm(ALPHA * x + ffn, ln2_g[l], ln2_b[l])
    return x, (k, v, ki, s_new.astype(x.dtype), sc_new, ffn_new)


def setup_inputs(seed: int = 0) -> dict:
    key = jax.random.key(seed)
    ks = jax.random.split(key, 24)

    def nrm(k, shape, scale=1.0):
        return jax.random.normal(k, shape, jnp.float32) * scale

    return {
        'x_prompt': nrm(ks[0], (BATCH, SEQ, D_MODEL)),
        'x_sample': nrm(ks[1], (DEC_BATCH, DEC_SEQ, D_MODEL)),
        'cache_attn_k': nrm(ks[2], (DEPTH, DEC_BATCH, PAST_LEN, KV_HEADS, HEAD_DIM)),
        'cache_attn_v': nrm(ks[3], (DEPTH, DEC_BATCH, PAST_LEN, KV_HEADS, HEAD_DIM)),
        'cache_idx_k': nrm(ks[4], (DEPTH, DEC_BATCH, PAST_LEN, IDX_DIM)),
        'state_hgrn': nrm(ks[5], (DEPTH, DEC_BATCH, HGRN_HEADS, HGRN_DK, HGRN_DV), 0.3),
        'state_sconv': nrm(ks[6], (DEPTH, DEC_BATCH, CONV_W - 1, SCONV_WIDTH)),
        'state_ffn_conv': nrm(ks[7], (DEPTH, DEC_BATCH, CONV_W - 1, 2 * D_FF)),
        'w_in': nrm(ks[8], (DEPTH, D_MODEL, IN_COLS), D_MODEL ** -0.5),
        'hgrn_lb_logits': nrm(ks[9], (DEPTH, HGRN_HEADS * HGRN_DK), 0.5),
        'hgrn_norm_g': 1.0 + nrm(ks[10], (DEPTH, HGRN_DV), 0.02),
        'sconv_w': nrm(ks[11], (DEPTH, CONV_W, SCONV_WIDTH), CONV_W ** -0.5),
        'sconv_b': nrm(ks[12], (DEPTH, SCONV_WIDTH), 0.02),
        'w_branch': nrm(ks[13], (DEPTH, N_BRANCH, BRANCH_WIDTH, D_MODEL), BETA * BRANCH_WIDTH ** -0.5),
        'w_out': nrm(ks[14], (DEPTH, D_MODEL, D_MODEL), BETA * D_MODEL ** -0.5),
        'ln1_g': 1.0 + nrm(ks[15], (DEPTH, D_MODEL), 0.02),
        'ln1_b': nrm(ks[16], (DEPTH, D_MODEL), 0.02),
        'w_up': nrm(ks[17], (DEPTH, D_MODEL, 2 * D_FF), D_MODEL ** -0.5),
        'ffn_conv_w': nrm(ks[18], (DEPTH, CONV_W, 2 * D_FF), CONV_W ** -0.5),
        'ffn_conv_b': nrm(ks[19], (DEPTH, 2 * D_FF), 0.02),
        'w_down': nrm(ks[20], (DEPTH, D_FF, D_MODEL), BETA * D_FF ** -0.5),
        'ln2_g': 1.0 + nrm(ks[21], (DEPTH, D_MODEL), 0.02),
        'ln2_b': nrm(ks[22], (DEPTH, D_MODEL), 0.02),
    }


def reference(x_prompt, x_sample, cache_attn_k, cache_attn_v, cache_idx_k, state_hgrn, state_sconv,
              state_ffn_conv, w_in, hgrn_lb_logits, hgrn_norm_g, sconv_w, sconv_b, w_branch, w_out,
              ln1_g, ln1_b, w_up, ffn_conv_w, ffn_conv_b, w_down, ln2_g, ln2_b):
    weights = (w_in, hgrn_lb_logits, hgrn_norm_g, sconv_w, sconv_b, w_branch, w_out, ln1_g, ln1_b,
               w_up, ffn_conv_w, ffn_conv_b, w_down, ln2_g, ln2_b)
    B, S, _ = x_prompt.shape
    DB, DS, _ = x_sample.shape
    P = cache_attn_k.shape[2]
    pos_p = jnp.arange(S)
    pos_s = P + jnp.arange(DS)
    xp, xs = x_prompt, x_sample
    st_p = [[] for _ in range(6)]
    st_s = [[] for _ in range(6)]
    for l in range(DEPTH):
        xp, new_p = trunk_layer(
            xp, pos_p, None, None, None,
            jnp.zeros((B, HGRN_HEADS, HGRN_DK, HGRN_DV), jnp.float32),
            jnp.zeros((B, CONV_W - 1, SCONV_WIDTH), xp.dtype),
            jnp.zeros((B, CONV_W - 1, 2 * D_FF), xp.dtype), l, weights)
        xs, new_s = trunk_layer(
            xs, pos_s, cache_attn_k[l], cache_attn_v[l], cache_idx_k[l], state_hgrn[l],
            state_sconv[l], state_ffn_conv[l], l, weights)
        for j in range(6):
            st_p[j].append(new_p[j])
            st_s[j].append(new_s[j])
    k_p, v_p, ki_p, h_p, sc_p, ff_p = [jnp.stack(a, axis=0) for a in st_p]
    k_s, v_s, ki_s, h_s, sc_s, ff_s = [jnp.stack(a, axis=0) for a in st_s]
    return (xp, xs, k_p, v_p, ki_p, h_p, sc_p, ff_p, k_s, v_s, ki_s, h_s, sc_s, ff_s)
```

```cpp
#include <hip/hip_runtime.h>
#include <hip/hip_cooperative_groups.h>
#include <hip/hip_fp16.h>
#include <cstdio>
namespace cg = cooperative_groups;
#define DBG_NPH NPH
#define DBG_ATTN 1

#define LAS __attribute__((address_space(3)))
typedef unsigned short bf16_t;
typedef short bf16x8 __attribute__((ext_vector_type(8)));
typedef float f32x4 __attribute__((ext_vector_type(4)));
typedef unsigned u32x4 __attribute__((ext_vector_type(4)));
typedef unsigned u32x2 __attribute__((ext_vector_type(2)));

constexpr int D = 1024, SEQ = 8192, NB = 4, DB = 8, DS = 64, PAST = 2048, LCAT = PAST + DS;
constexpr int INC = 7748, NP1 = 7936, DFF = 2816, NUP = 5632;
constexpr float ALPHA = 1.41421356237309515f, LN_EPS = 1e-5f, IDX_SCALE = 0.0625f;
constexpr int TGMAX = 16384;
constexpr size_t MiB = 1u << 20;
constexpr size_t O_YP = 0, O_YS = O_YP + (size_t)NB * SEQ * D, O_KP = O_YS + (size_t)DB * DS * D, O_VP = O_KP + (size_t)2 * NB * SEQ * 128,
                 O_KIP = O_VP + (size_t)2 * NB * SEQ * 128, O_HP = O_KIP + (size_t)2 * NB * SEQ * 64, O_SCP = O_HP + (size_t)2 * NB * 4 * 16384,
                 O_FFP = O_SCP + (size_t)2 * NB * 2 * 512, O_KS = O_FFP + (size_t)2 * NB * 2 * NUP, O_VS = O_KS + (size_t)2 * DB * DS * 128,
                 O_KIS = O_VS + (size_t)2 * DB * DS * 128, O_HS = O_KIS + (size_t)2 * DB * DS * 64, O_SCS = O_HS + (size_t)2 * DB * 4 * 16384,
                 O_FFS = O_SCS + (size_t)2 * DB * 2 * 512;
constexpr size_t W_IN = 0, W_BR = W_IN + (size_t)NP1 * 1024 * 2, W_OUT = W_BR + (size_t)3 * 1024 * 512 * 2, W_UP = W_OUT + (size_t)1024 * 1024 * 2,
                 W_DN = W_UP + (size_t)NUP * 1024 * 2, W_END = W_DN + (size_t)1024 * DFF * 2;
constexpr size_t WL = 37 * MiB, OFF_ROT = 74 * MiB, OFF_BAR = 74 * MiB + 768 * 1024, AR = 75 * MiB;
constexpr size_t A_XB = AR, A_Q = AR + 32 * MiB, A_KB = AR + 48 * MiB, A_VB = AR + 52 * MiB + MiB / 2, A_QI = AR + 57 * MiB, A_KIB = AR + 65 * MiB,
                 A_IW = AR + 67 * MiB + MiB / 4, A_HQ = AR + 68 * MiB, A_LF = AR + 84 * MiB, A_KH = AR + 100 * MiB, A_HV = AR + 116 * MiB, A_HG = AR + 132 * MiB,
                 A_CB = AR + 148 * MiB, A_U = AR + 164 * MiB, A_GATES = AR + 180 * MiB, A_YA = AR + 276 * MiB, A_ST = AR + 324 * MiB, A_DEC = AR + 356 * MiB,
                 A_MPART = AR + 68 * MiB, A_MERGED = AR + 32 * MiB, A_X1 = AR + 88 * MiB, A_X1B = AR + 152 * MiB, A_H = AR + 184 * MiB, A_G = AR;
constexpr size_t OFF_XB2 = 460 * MiB;
static_assert(OFF_XB2 + 32 * MiB <= 512 * MiB, "xb2 overflow");
constexpr size_t SAR = 436 * MiB, S_KB = 448 * MiB, S_VB = 452 * MiB + MiB / 2, S_KIB = 457 * MiB;
static_assert(S_KIB + 3 * MiB <= 512 * MiB, "sample arena overflow");
static_assert(W_END <= WL, "weights overflow");
static_assert(A_H + (size_t)TGMAX * NUP * 2 <= 512 * MiB && A_DEC + MiB <= 512 * MiB, "arena overflow");

struct Params {
    const float *x_prompt, *x_sample, *cache_k, *cache_v, *cache_ik, *state_hgrn, *state_sconv, *state_ffn;
    const float *w_in, *lb_logits, *norm_g, *sconv_w, *sconv_b, *w_branch, *w_out, *ln1_g, *ln1_b, *w_up, *ffn_cw, *ffn_cb, *w_down, *ln2_g, *ln2_b;
    float* out; unsigned char* ws;
    int lo, hi, coop, pad;
};

typedef float f32x2_ __attribute__((ext_vector_type(2)));
typedef __bf16 bf16x2_ __attribute__((ext_vector_type(2)));
__device__ __forceinline__ unsigned cvt_pk_bf16(float lo, float hi) { const f32x2_ v = {lo, hi}; const bf16x2_ b = __builtin_convertvector(v, bf16x2_); return __builtin_bit_cast(unsigned, b); }
__device__ __forceinline__ float bflo(unsigned w) { return __uint_as_float(w << 16); }
__device__ __forceinline__ float bfhi(unsigned w) { return __uint_as_float(w & 0xffff0000u); }
__device__ __forceinline__ float bf2f(bf16_t b) { return __uint_as_float(((unsigned)b) << 16); }
__device__ __forceinline__ bf16_t f2bf(float f) { return (bf16_t)(cvt_pk_bf16(f, 0.f) & 0xffffu); }
__device__ __forceinline__ u32x4 pack8(const f32x4 a, const f32x4 b) { u32x4 w; w.x = cvt_pk_bf16(a[0], a[1]); w.y = cvt_pk_bf16(a[2], a[3]); w.z = cvt_pk_bf16(b[0], b[1]); w.w = cvt_pk_bf16(b[2], b[3]); return w; }
__device__ __forceinline__ void unpack8(const u32x4 w, float* f) { f[0] = bflo(w.x); f[1] = bfhi(w.x); f[2] = bflo(w.y); f[3] = bfhi(w.y); f[4] = bflo(w.z); f[5] = bfhi(w.z); f[6] = bflo(w.w); f[7] = bfhi(w.w); }
__device__ __forceinline__ float fsigmoid(float x) { return __builtin_amdgcn_rcpf(1.0f + __expf(-x)); }
__device__ __forceinline__ float fsilu(float x) { return x * fsigmoid(x); }
__device__ __forceinline__ int mbcnt64(unsigned long long m) { return __builtin_amdgcn_mbcnt_hi((unsigned)(m >> 32), __builtin_amdgcn_mbcnt_lo((unsigned)m, 0u)); }
__device__ __forceinline__ int tid_opaque() { int t = threadIdx.x; asm volatile("" : "+v"(t)); return t; }
template <class T> __device__ __forceinline__ T* sgpr_opaque(T* p) {
    unsigned lo = (unsigned)(unsigned long long)p, hi = (unsigned)((unsigned long long)p >> 32);
    lo = __builtin_amdgcn_readfirstlane(lo); hi = __builtin_amdgcn_readfirstlane(hi);
    asm volatile("" : "+s"(lo), "+s"(hi));
    return (T*)(((unsigned long long)hi << 32) | (unsigned long long)lo);
}
#define MFMA16(a, b, c) __builtin_amdgcn_mfma_f32_16x16x32_bf16((a), (b), (c), 0, 0, 0)

constexpr int BM = 256, BK = 64, HALF = 128, HTB = HALF * BK * 2, NXCD = 8, WGM = 8;
__device__ __forceinline__ int lds_byte(int r, int c) { const int st = (r >> 4) * 2 + (c >> 5), rr = r & 15, cc = c & 31, ob = rr * 64 + cc * 2; return st * 1024 + (ob ^ (((ob >> 9) & 1) << 5)); }
__device__ __forceinline__ void stage_rc(int b, int& R, int& C) { const int st = b / 1024, sb = b % 1024, swz = sb ^ (((sb >> 9) & 1) << 5); R = (st >> 1) * 16 + swz / 64; C = (st & 1) * 32 + (swz % 64) / 2; }
__device__ __forceinline__ int perm32(int rho) { const int n = rho >> 4, i = rho & 15; return 8 * (i >> 2) + 4 * n + (i & 3); }
struct Unit { int pm, pn, z; };
struct Gemm { const bf16_t* A; const bf16_t* Bt; int K; size_t zA, zB; };
struct TileOrder {
    int nM, nN, nwg, G, c, NZ;
    __device__ void init(int M, int N, int G_, int c_, int nz) { nM = M / BM; nN = N / BM; nwg = nM * nN; G = G_; c = c_; NZ = nz; }
    __device__ bool next(int i, Unit& u) const {
        const int it = i / NZ; u.z = i - it * NZ;
        const long L = (long)it * G + c; if (L >= nwg) return false;
        int wgid = (int)L; { const int q = nwg / NXCD, r = nwg % NXCD, xcd = wgid % NXCD, off = wgid / NXCD; wgid = (xcd < r ? xcd * (q + 1) : r * (q + 1) + (xcd - r) * q) + off; }
        const int nig = WGM * nN, gid = wgid / nig, fm = gid * WGM, gsz = (nM - fm) < WGM ? (nM - fm) : WGM;
        u.pm = fm + ((wgid % nig) % gsz); u.pn = (wgid % nig) / gsz; return true;
    }
};
template <class Epi>
__device__ __forceinline__ void gemm_phase(LAS unsigned char* lds, const Gemm g, const TileOrder& S, const Epi& E) {
    const int tid = tid_opaque(), wid = __builtin_amdgcn_readfirstlane(tid >> 6), lane = tid & 63, wr = wid >> 2, wc = wid & 3, fr = lane & 15, fq = lane >> 4;
    const int K = g.K, nt = K / BK;
    unsigned voffA[2], voffB[2];
#pragma unroll
    for (int i = 0; i < 2; ++i) { int R, C; stage_rc(tid * 16 + i * 8192, R, C); const int Rb = (R & ~31) + perm32(R & 31);
        voffA[i] = (unsigned)(R * K + C) * 2u; voffB[i] = (unsigned)(Rb * K + C) * 2u; }
    const size_t kstep = (size_t)(BK * 2), hstep = (size_t)HALF * K * 2, tstep = 2 * hstep;
    const unsigned ldsw = (unsigned)wid * 1024u;
    const int aoff = lds_byte(wr * 64 + fr, fq * 8), boff = lds_byte(wc * 32 + fr, fq * 8);
#define PG_SA(b, h) (((b) * 2 + (h)) * HTB)
#define PG_SB(b, h) ((4 + (b) * 2 + (h)) * HTB)
#define PG_STAGE(bufoff, gbase, voff) do { _Pragma("unroll") for (int _i = 0; _i < 2; ++_i) \
        __builtin_amdgcn_global_load_lds((const unsigned*)((const char*)(gbase) + (voff)[_i]), (LAS unsigned*)(lds + (bufoff) + ldsw + _i * 8192), 16, 0, 0); } while (0)
#define PG_LDA(dst, b, h) do { _Pragma("unroll") for (int m = 0; m < 4; ++m) _Pragma("unroll") for (int k = 0; k < 2; ++k) dst[m][k] = *(const LAS bf16x8*)(lds + PG_SA(b, h) + aoff + m * 2048 + k * 1024); } while (0)
#define PG_LDB(dst, b, h) do { _Pragma("unroll") for (int n = 0; n < 2; ++n) _Pragma("unroll") for (int k = 0; k < 2; ++k) dst[n][k] = *(const LAS bf16x8*)(lds + PG_SB(b, h) + boff + n * 2048 + k * 1024); } while (0)
#define PG_MMA(ai, bj, At, Bt) do { __builtin_amdgcn_s_setprio(1); _Pragma("unroll") for (int m = 0; m < 4; ++m) _Pragma("unroll") for (int n = 0; n < 2; ++n) _Pragma("unroll") for (int k = 0; k < 2; ++k) \
        acc[ai][bj][m][n] = __builtin_amdgcn_mfma_f32_16x16x32_bf16(Bt[n][k], At[m][k], acc[ai][bj][m][n], 0, 0, 0); __builtin_amdgcn_s_setprio(0); } while (0)
#define PG_WAIT_V(n) asm volatile("s_waitcnt vmcnt(" #n ")" ::: "memory")
#define PG_WAIT_L(n) asm volatile("s_waitcnt lgkmcnt(" #n ")" ::: "memory")
#define PG_BAR __builtin_amdgcn_s_barrier()
#define PG_SCHED __builtin_amdgcn_sched_barrier(0)
    Unit cur, nxt; int ui = 0;
    if (!S.next(0, cur)) return;
    f32x4 acc[2][2][4][2];
#pragma unroll
    for (int a = 0; a < 2; ++a)
#pragma unroll
        for (int b = 0; b < 2; ++b)
#pragma unroll
            for (int m = 0; m < 4; ++m)
#pragma unroll
                for (int n = 0; n < 2; ++n) acc[a][b][m][n] = (f32x4){0.f, 0.f, 0.f, 0.f};
    bf16x8 At[4][2], B0[2][2], B1[2][2];
    const char* cA = (const char*)g.A + ((size_t)cur.z * g.zA) * 2 + (size_t)cur.pm * tstep; const char* cB = (const char*)g.Bt + ((size_t)cur.z * g.zB) * 2 + (size_t)cur.pn * tstep;
    PG_STAGE(PG_SB(0, 0), cB, voffB); PG_STAGE(PG_SA(0, 0), cA, voffA); PG_STAGE(PG_SB(0, 1), cB + hstep, voffB); PG_STAGE(PG_SA(0, 1), cA + hstep, voffA);
    if (wr == 1) PG_BAR;
    PG_WAIT_V(4); PG_BAR;
    PG_STAGE(PG_SB(1, 0), cB + kstep, voffB); PG_STAGE(PG_SA(1, 0), cA + kstep, voffA); PG_STAGE(PG_SB(1, 1), cB + hstep + kstep, voffB);
    PG_WAIT_V(6); PG_BAR;
    for (;;) {
        const bool has_next = S.next(ui + 1, nxt);
        const char* nA = has_next ? (const char*)g.A + ((size_t)nxt.z * g.zA) * 2 + (size_t)nxt.pm * tstep : cA;
        const char* nB = has_next ? (const char*)g.Bt + ((size_t)nxt.z * g.zB) * 2 + (size_t)nxt.pn * tstep : cB;
        for (int t = 0; t < nt; t += 2) {
            const bool last = (t == nt - 2);
            const char* a1 = cA + (size_t)(t + 1) * kstep;
            const char* a2 = last ? nA : cA + (size_t)(t + 2) * kstep; const char* b2 = last ? nB : cB + (size_t)(t + 2) * kstep;
            const char* a3 = a2 + kstep; const char* b3 = b2 + kstep;
            if constexpr (Epi::HOOK) { if (t == 8 || t == 16) E.mid(acc, cur, wr, wc, fr, fq, t >> 3); }
            PG_LDB(B0, 0, 0); PG_SCHED; PG_LDA(At, 0, 0); PG_STAGE(PG_SA(1, 1), a1 + hstep, voffA);
            PG_WAIT_L(8); PG_BAR; PG_WAIT_L(0); PG_MMA(0, 0, At, B0); PG_BAR; PG_SCHED;
            PG_LDB(B1, 0, 1); PG_STAGE(PG_SB(0, 0), b2, voffB);
            PG_BAR; PG_WAIT_L(0); PG_MMA(0, 1, At, B1); PG_BAR;
            PG_LDA(At, 0, 1); PG_STAGE(PG_SA(0, 0), a2, voffA);
            PG_BAR; PG_WAIT_L(0); PG_MMA(1, 0, At, B0); PG_BAR; PG_SCHED;
            PG_STAGE(PG_SB(0, 1), b2 + hstep, voffB);
            PG_WAIT_V(6); PG_BAR; PG_MMA(1, 1, At, B1); PG_BAR;
            PG_LDB(B0, 1, 0); PG_SCHED; PG_LDA(At, 1, 0); PG_STAGE(PG_SA(0, 1), a2 + hstep, voffA);
            PG_WAIT_L(8); PG_BAR; PG_WAIT_L(0); PG_MMA(0, 0, At, B0); PG_BAR; PG_SCHED;
            PG_LDB(B1, 1, 1); PG_STAGE(PG_SB(1, 0), b3, voffB);
            PG_BAR; PG_WAIT_L(0); PG_MMA(0, 1, At, B1); PG_BAR;
            PG_LDA(At, 1, 1); PG_STAGE(PG_SA(1, 0), a3, voffA);
            PG_BAR; PG_WAIT_L(0); PG_MMA(1, 0, At, B0); PG_BAR; PG_SCHED;
            PG_STAGE(PG_SB(1, 1), b3 + hstep, voffB);
            PG_WAIT_V(6); PG_BAR; PG_MMA(1, 1, At, B1); PG_BAR;
        }
        E(acc, cur, wr, wc, fr, fq);
        if (!has_next) break;
#pragma unroll
        for (int a = 0; a < 2; ++a)
#pragma unroll
            for (int b = 0; b < 2; ++b)
#pragma unroll
                for (int m = 0; m < 4; ++m)
#pragma unroll
                    for (int n = 0; n < 2; ++n) acc[a][b][m][n] = (f32x4){0.f, 0.f, 0.f, 0.f};
        cur = nxt; cA = nA; cB = nB; ++ui;
    }
    PG_WAIT_V(0);
    if (wr == 0) PG_BAR;
    PG_BAR;
}

struct GroupCtx {
    int sample, Tg, gbaseT, nbat, Lk;
    unsigned char *ab, *kb, *vb, *kib; int sh, rev;
};
#define AX(gc_, A_) ((gc_).ab + ((size_t)((A_) - AR) >> (gc_).sh))
__device__ __forceinline__ void rotary8(f32x4& v0, f32x4& v1, const float2* rr, bool act, int fq) {
    f32x4 p0, p1;
#pragma unroll
    for (int j = 0; j < 4; ++j) { p0[j] = __shfl_xor(v0[j], 16); p1[j] = __shfl_xor(v1[j], 16); }
    if (act) {
#pragma unroll
        for (int j = 0; j < 4; ++j) { const float2 c0 = rr[j], c1 = rr[4 + j]; const float s0 = fq ? c0.y : -c0.y, s1 = fq ? c1.y : -c1.y;
            v0[j] = v0[j] * c0.x + p0[j] * s0; v1[j] = v1[j] * c1.x + p1[j] * s1; }
    }
}
struct Epi1 {
    static constexpr bool HOOK = false;
    unsigned char* ws; float* out; const float* lbl;
    int layer; GroupCtx gc;
    __device__ __forceinline__ void operator()(const f32x4 (&acc)[2][2][4][2], const Unit& un, int wr, int wc, int fr_, int fq_) const {
        int fr = fr_, fq = fq_; asm volatile("" : "+v"(fr), "+v"(fq));
        const int pn = un.pn; unsigned char* const ws = sgpr_opaque(this->ws);
        bf16_t* const q = (bf16_t*)AX(gc, A_Q); bf16_t* const kbuf = (bf16_t*)gc.kb; bf16_t* const vbuf = (bf16_t*)gc.vb; bf16_t* const qi = (bf16_t*)AX(gc, A_QI); bf16_t* const kibuf = (bf16_t*)gc.kib;
        bf16_t* const hq = (bf16_t*)AX(gc, A_HQ); bf16_t* const lf = (bf16_t*)AX(gc, A_LF); bf16_t* const kh = (bf16_t*)AX(gc, A_KH); bf16_t* const hv = (bf16_t*)AX(gc, A_HV); bf16_t* const hg = (bf16_t*)AX(gc, A_HG);
        bf16_t* const cb = (bf16_t*)AX(gc, A_CB); bf16_t* const u = (bf16_t*)AX(gc, A_U); bf16_t* const gates = (bf16_t*)AX(gc, A_GATES); float* const iw = (float*)AX(gc, A_IW);
        const float2* const rot = (const float2*)(ws + OFF_ROT);
        const size_t l_ = (size_t)layer;
        float* const outk = gc.sample ? out + O_KS + l_ * DB * DS * 128 : out + O_KP + (l_ * NB * SEQ + gc.gbaseT) * 128;
        float* const outv = gc.sample ? out + O_VS + l_ * DB * DS * 128 : out + O_VP + (l_ * NB * SEQ + gc.gbaseT) * 128;
        float* const outki = gc.sample ? out + O_KIS + l_ * DB * DS * 64 : out + O_KIP + (l_ * NB * SEQ + gc.gbaseT) * 64;
        float* const outsc = gc.sample ? out + O_SCS + l_ * DB * 2 * 512 : out + O_SCP + l_ * NB * 2 * 512;
#pragma unroll
        for (int ai = 0; ai < 2; ++ai)
#pragma unroll
            for (int m = 0; m < 4; ++m) {
                const int row = un.pm * BM + ai * HALF + wr * 64 + m * 16 + fr;
                int pos, krow, bidx;
                if (gc.sample) { pos = PAST + (row & 63); bidx = row >> 6; krow = bidx * LCAT + pos; } else { pos = (gc.gbaseT + row) & (SEQ - 1); bidx = (gc.gbaseT + row) >> 13; krow = row; }
                const float2* rr = rot + (size_t)pos * 8;
                const bool ract = ((wc & 1) == 0) && (fq < 2);
#pragma unroll
                for (int bj = 0; bj < 2; ++bj) {
                    f32x4 v0 = acc[ai][bj][m][0], v1 = acc[ai][bj][m][1];
                    const int c8 = bj * HALF + wc * 32 + fq * 8;
                    if (pn < 2) {
                        if ((wc & 1) == 0) rotary8(v0, v1, rr, ract, fq);
                        *(u32x4*)(q + (size_t)row * 512 + pn * 256 + c8) = pack8(v0 * 0.125f, v1 * 0.125f);
                    } else if (pn == 2) {
                        if (bj == 0) { if ((wc & 1) == 0) rotary8(v0, v1, rr, ract, fq);
                            float* o = outk + (size_t)row * 128 + (c8 & 127); *(f32x4*)o = v0; *(f32x4*)(o + 4) = v1;
                            *(u32x4*)(kbuf + (size_t)krow * 128 + (c8 & 127)) = pack8(v0, v1);
                        } else { float* o = outv + (size_t)row * 128 + (c8 & 127); *(f32x4*)o = v0; *(f32x4*)(o + 4) = v1;
                            *(u32x4*)(vbuf + (size_t)krow * 128 + (c8 & 127)) = pack8(v0, v1); }
                    } else if (pn == 3) {
                        if ((wc & 1) == 0) rotary8(v0, v1, rr, ract, fq);
                        *(u32x4*)(qi + (size_t)row * 256 + c8) = pack8(v0, v1);
                    } else if (pn == 4) {
                        if (bj == 0) {
                            if (wc == 0) rotary8(v0, v1, rr, ract, fq);
                            if (wc < 2) { float* o = outki + (size_t)row * 64 + c8; *(f32x4*)o = v0; *(f32x4*)(o + 4) = v1;
                                *(u32x4*)(kibuf + (size_t)krow * 64 + c8) = pack8(v0, v1); }
                            else if (wc == 2 && fq == 0) *(f32x4*)(iw + (size_t)row * 4) = v0 * IDX_SCALE;
                        }
                    } else if (pn < 7) {
#pragma unroll
                        for (int j = 0; j < 4; ++j) { v0[j] = fsilu(v0[j]); v1[j] = fsilu(v1[j]); }
                        *(u32x4*)(hq + (size_t)row * 512 + (pn - 5) * 256 + c8) = pack8(v0, v1);
                    } else if (pn < 9) {
                        const int c = (pn - 7) * 256 + c8; f32x4 l0, l1, k0, k1;
#pragma unroll
                        for (int j = 0; j < 4; ++j) {
                            float lb0 = 0.f, lb1 = 0.f;
                            if (layer == 1) { lb0 = fsigmoid(lbl[512 + c + j] - lbl[c + j]); lb1 = fsigmoid(lbl[512 + c + 4 + j] - lbl[c + 4 + j]); }
                            const float f0 = lb0 + (1.f - lb0) * fsigmoid(v0[j]), f1 = lb1 + (1.f - lb1) * fsigmoid(v1[j]);
                            l0[j] = __logf(f0); l1[j] = __logf(f1); k0[j] = 1.f - f0; k1[j] = 1.f - f1; }
                        *(u32x4*)(lf + (size_t)row * 512 + c) = pack8(l0, l1); *(u32x4*)(kh + (size_t)row * 512 + c) = pack8(k0, k1);
                    } else if (pn < 11) {
                        *(u32x4*)(hv + (size_t)row * 512 + (pn - 9) * 256 + c8) = pack8(v0, v1);
                    } else if (pn < 13) {
#pragma unroll
                        for (int j = 0; j < 4; ++j) { v0[j] = fsilu(v0[j]); v1[j] = fsilu(v1[j]); }
                        *(u32x4*)(hg + (size_t)row * 512 + (pn - 11) * 256 + c8) = pack8(v0, v1);
                    } else if (pn < 15) {
                        *(u32x4*)(cb + (size_t)row * 512 + (pn - 13) * 256 + c8) = pack8(v0, v1);
                    } else if (pn < 19) {
                        if (bj == 1) { const f32x4 a0 = acc[ai][0][m][0] * v0, a1 = acc[ai][0][m][1] * v1; const int c = (pn - 15) * 128 + wc * 32 + fq * 8;
                            *(u32x4*)(u + (size_t)row * 512 + c) = pack8(a0, a1);
                            const int lastp = gc.sample ? (PAST + DS - 2) : (SEQ - 2);
                            if (pos >= lastp) { float* o = outsc + (size_t)(bidx * 2 + (pos - lastp)) * 512 + c; *(f32x4*)o = a0; *(f32x4*)(o + 4) = a1; } }
                    } else {
#pragma unroll
                        for (int j = 0; j < 4; ++j) { v0[j] = fsigmoid(v0[j]); v1[j] = fsigmoid(v1[j]); }
                        *(u32x4*)(gates + (size_t)row * 3072 + (pn - 19) * 256 + c8) = pack8(v0, v1);
                    }
                }
            }
    }
};
struct EpiMerge {
    static constexpr bool HOOK = true;
    const bf16_t* gates; bf16_t* merged;
    __device__ __forceinline__ void mid(f32x4 (&acc)[2][2][4][2], const Unit& un, int wr, int wc, int fr_, int fq_, int b) const {
        int fr = fr_, fq = fq_; asm volatile("" : "+v"(fr), "+v"(fq));
#pragma unroll
        for (int ai = 0; ai < 2; ++ai)
#pragma unroll
            for (int m = 0; m < 4; ++m) {
                const int row = un.pm * BM + ai * HALF + wr * 64 + m * 16 + fr;
#pragma unroll
                for (int bj = 0; bj < 2; ++bj) {
                    const int c = un.pn * BM + bj * HALF + wc * 32 + fq * 8;
                    const bf16_t* gp = gates + (size_t)row * 3072 + (b - 1) * 1024 + c;
                    float g0[8], g1[8]; unpack8(*(const u32x4*)gp, g0); unpack8(*(const u32x4*)(gp + 1024), g1);
#pragma unroll
                    for (int j = 0; j < 4; ++j) {
                        acc[ai][bj][m][0][j] *= fmaxf(g0[j], 1e-30f) * __builtin_amdgcn_rcpf(fmaxf(g1[j], 1e-30f));
                        acc[ai][bj][m][1][j] *= fmaxf(g0[4 + j], 1e-30f) * __builtin_amdgcn_rcpf(fmaxf(g1[4 + j], 1e-30f)); }
                }
            }
    }
    __device__ __forceinline__ void operator()(const f32x4 (&acc)[2][2][4][2], const Unit& un, int wr, int wc, int fr_, int fq_) const {
        int fr = fr_, fq = fq_; asm volatile("" : "+v"(fr), "+v"(fq));
#pragma unroll
        for (int ai = 0; ai < 2; ++ai)
#pragma unroll
            for (int m = 0; m < 4; ++m) {
                const int row = un.pm * BM + ai * HALF + wr * 64 + m * 16 + fr;
#pragma unroll
                for (int bj = 0; bj < 2; ++bj) {
                    const int c = un.pn * BM + bj * HALF + wc * 32 + fq * 8;
                    float gf[8]; unpack8(*(const u32x4*)(gates + (size_t)row * 3072 + 2048 + c), gf);
                    f32x4 v0 = acc[ai][bj][m][0], v1 = acc[ai][bj][m][1];
#pragma unroll
                    for (int j = 0; j < 4; ++j) { v0[j] *= fmaxf(gf[j], 1e-30f); v1[j] *= fmaxf(gf[4 + j], 1e-30f); }
                    *(u32x4*)(merged + (size_t)row * 1024 + c) = pack8(v0, v1);
                }
            }
    }
};
struct EpiRes {
    static constexpr bool HOOK = false;
    const float* res; float* dst;
    __device__ __forceinline__ void operator()(const f32x4 (&acc)[2][2][4][2], const Unit& un, int wr, int wc, int fr_, int fq_) const {
        int fr = fr_, fq = fq_; asm volatile("" : "+v"(fr), "+v"(fq));
#pragma unroll
        for (int ai = 0; ai < 2; ++ai)
#pragma unroll
            for (int m = 0; m < 4; ++m) {
                const int row = un.pm * BM + ai * HALF + wr * 64 + m * 16 + fr;
#pragma unroll
                for (int bj = 0; bj < 2; ++bj) {
                    const size_t o = (size_t)row * 1024 + un.pn * BM + bj * HALF + wc * 32 + fq * 8;
                    const f32x4 r0 = *(const f32x4*)(res + o), r1 = *(const f32x4*)(res + o + 4);
                    *(f32x4*)(dst + o) = r0 * ALPHA + acc[ai][bj][m][0]; *(f32x4*)(dst + o + 4) = r1 * ALPHA + acc[ai][bj][m][1];
                }
            }
    }
};
struct EpiUp {
    static constexpr bool HOOK = false;
    bf16_t* h; float* outff; GroupCtx gc;
    __device__ __forceinline__ void operator()(const f32x4 (&acc)[2][2][4][2], const Unit& un, int wr, int wc, int fr_, int fq_) const {
        int fr = fr_, fq = fq_; asm volatile("" : "+v"(fr), "+v"(fq));
#pragma unroll
        for (int ai = 0; ai < 2; ++ai)
#pragma unroll
            for (int m = 0; m < 4; ++m) {
                const int row = un.pm * BM + ai * HALF + wr * 64 + m * 16 + fr;
                int sp, bidx, S_;
                if (gc.sample) { sp = row & 63; bidx = row >> 6; S_ = DS; } else { sp = (gc.gbaseT + row) & (SEQ - 1); bidx = (gc.gbaseT + row) >> 13; S_ = SEQ; }
#pragma unroll
                for (int bj = 0; bj < 2; ++bj) {
                    const int c = un.pn * BM + bj * HALF + wc * 32 + fq * 8;
                    *(u32x4*)(h + (size_t)row * NUP + c) = pack8(acc[ai][bj][m][0], acc[ai][bj][m][1]);
                    if (sp >= S_ - 2) { float* o = outff + (size_t)(bidx * 2 + (sp - (S_ - 2))) * NUP + c; *(f32x4*)o = acc[ai][bj][m][0]; *(f32x4*)(o + 4) = acc[ai][bj][m][1]; }
                }
            }
    }
};

__device__ __forceinline__ float dpp_ror1(float x) { return __int_as_float(__builtin_amdgcn_update_dpp(0, __float_as_int(x), 0x121, 0xf, 0xf, false)); }
__device__ __forceinline__ float dpp_ror2(float x) { return __int_as_float(__builtin_amdgcn_update_dpp(0, __float_as_int(x), 0x122, 0xf, 0xf, false)); }
struct EpiUpConv {
    static constexpr bool HOOK = false;
    bf16_t* gout; float* halo; float* outff; const float* cw; const float* cbias; GroupCtx gc;
    __device__ __forceinline__ void operator()(const f32x4 (&acc)[2][2][4][2], const Unit& un, int wr, int wc, int fr_, int fq_) const {
        int fr = fr_, fq = fq_; asm volatile("" : "+v"(fr), "+v"(fq));
#pragma unroll
        for (int n = 0; n < 2; ++n) {
            const int ca = un.pn * 128 + wc * 32 + fq * 8 + 4 * n;
            const f32x4 wa0 = *(const f32x4*)(cw + ca), wa1 = *(const f32x4*)(cw + NUP + ca), wa2 = *(const f32x4*)(cw + 2 * NUP + ca), ba = *(const f32x4*)(cbias + ca);
            const f32x4 wb0 = *(const f32x4*)(cw + DFF + ca), wb1 = *(const f32x4*)(cw + NUP + DFF + ca), wb2 = *(const f32x4*)(cw + 2 * NUP + DFF + ca), bb = *(const f32x4*)(cbias + DFF + ca);
#pragma unroll
            for (int ai = 0; ai < 2; ++ai)
#pragma unroll
                for (int m = 0; m < 4; ++m) {
                    const int row = un.pm * BM + ai * HALF + wr * 64 + m * 16 + fr;
                    const f32x4 ha = acc[ai][0][m][n], hb = acc[ai][1][m][n];
                    const f32x4 pa = acc[ai][0][m > 0 ? m - 1 : 0][n], pb = acc[ai][1][m > 0 ? m - 1 : 0][n];
                    f32x4 oa, ob;
#pragma unroll
                    for (int j = 0; j < 4; ++j) {
                        const float a1 = dpp_ror1((m > 0 && fr == 15) ? pa[j] : ha[j]), a2 = dpp_ror2((m > 0 && fr >= 14) ? pa[j] : ha[j]);
                        const float b1 = dpp_ror1((m > 0 && fr == 15) ? pb[j] : hb[j]), b2 = dpp_ror2((m > 0 && fr >= 14) ? pb[j] : hb[j]);
                        oa[j] = ba[j] + wa0[j] * a2 + wa1[j] * a1 + wa2[j] * ha[j];
                        ob[j] = bb[j] + wb0[j] * b2 + wb1[j] * b1 + wb2[j] * hb[j];
                    }
                    if (!(m == 0 && fr < 2)) {
                        u32x2 wv; wv.x = cvt_pk_bf16(fsilu(oa[0]) * ob[0], fsilu(oa[1]) * ob[1]); wv.y = cvt_pk_bf16(fsilu(oa[2]) * ob[2], fsilu(oa[3]) * ob[3]);
                        *(u32x2*)(gout + (size_t)row * DFF + ca) = wv;
                    }
                    int slot = -1;
                    if (m == 3 && fr >= 14) slot = fr - 14; else if (m == 0 && fr < 2) slot = 2 + fr;
                    if (slot >= 0) { float* hp = halo + ((size_t)(row >> 6) * 4 + slot) * NUP + ca; *(f32x4*)hp = ha; *(f32x4*)(hp + DFF) = hb; }
                    if (m == 3 && fr >= 14) {
                        int sp, bidx, S_;
                        if (gc.sample) { sp = row & 63; bidx = row >> 6; S_ = DS; } else { sp = (gc.gbaseT + row) & (SEQ - 1); bidx = (gc.gbaseT + row) >> 13; S_ = SEQ; }
                        if (sp >= S_ - 2) { float* o = outff + (size_t)(bidx * 2 + (sp - (S_ - 2))) * NUP + ca; *(f32x4*)o = ha; *(f32x4*)(o + DFF) = hb; }
                    }
                }
        }
    }
};
__device__ __forceinline__ void phase_ffnfix(const Params& p, int l, const GroupCtx& gc, const float* __restrict__ halo, bf16_t* __restrict__ gout) {
    const float* cw = p.ffn_cw + (size_t)l * 3 * NUP; const float* cbias = p.ffn_cb + (size_t)l * NUP;
    const float* hist = p.state_ffn + (size_t)l * DB * 2 * NUP;
    constexpr int NC4 = DFF / 4; const int total = (gc.Tg / 64) * 2 * NC4;
    for (int e = blockIdx.x * 512 + tid_opaque(); e < total; e += gridDim.x * 512) {
        const int c = (e % NC4) * 4, rq = e / NC4, q = rq & 1, blk = rq >> 1, row = blk * 64 + q;
        int sp0, bidx; if (gc.sample) { sp0 = (blk * 64) & 63; bidx = blk; } else { sp0 = (gc.gbaseT + blk * 64) & (SEQ - 1); bidx = 0; }
        f32x4 o[2];
#pragma unroll
        for (int hf = 0; hf < 2; ++hf) {
            const int cc = c + hf * DFF;
            const float* hb = halo + (size_t)blk * 4 * NUP + cc;
            const f32x4 cur = *(const f32x4*)(hb + (size_t)(2 + q) * NUP);
            f32x4 p1, p2;
            if (sp0 > 0) { const float* hpv = halo + (size_t)(blk - 1) * 4 * NUP + cc;
                if (q == 0) { p1 = *(const f32x4*)(hpv + NUP); p2 = *(const f32x4*)hpv; } else { p1 = *(const f32x4*)(hb + 2 * NUP); p2 = *(const f32x4*)(hpv + NUP); } }
            else if (gc.sample) { const float* hs = hist + (size_t)bidx * 2 * NUP + cc;
                if (q == 0) { p1 = *(const f32x4*)(hs + NUP); p2 = *(const f32x4*)hs; } else { p1 = *(const f32x4*)(hb + 2 * NUP); p2 = *(const f32x4*)(hs + NUP); } }
            else { const f32x4 z = (f32x4){0.f, 0.f, 0.f, 0.f}; if (q == 0) { p1 = z; p2 = z; } else { p1 = *(const f32x4*)(hb + 2 * NUP); p2 = z; } }
            o[hf] = *(const f32x4*)(cbias + cc) + *(const f32x4*)(cw + cc) * p2 + *(const f32x4*)(cw + NUP + cc) * p1 + *(const f32x4*)(cw + 2 * NUP + cc) * cur;
        }
        u32x2 wv; wv.x = cvt_pk_bf16(fsilu(o[0][0]) * o[1][0], fsilu(o[0][1]) * o[1][1]); wv.y = cvt_pk_bf16(fsilu(o[0][2]) * o[1][2], fsilu(o[0][3]) * o[1][3]);
        *(u32x2*)(gout + (size_t)row * DFF + c) = wv;
    }
}

__device__ __forceinline__ int win_src_col(int n) {
    if (n < 1092) return n;
    if (n < 1280) return -1;
    if (n < 3840) return n - 188;
    if (n < 4864) { const int r = n - 3840, t = r >> 8, s = (r >> 7) & 1, i = r & 127; return (s ? 4164 : 3652) + 128 * t + i; }
    return n - 188;
}
__device__ __forceinline__ int up_src_col(int n) { return ((n >> 7) & 1) * DFF + (n >> 8) * 128 + (n & 127); }
template <int MAP> __device__ __forceinline__ void convT(const float* W, int ldw, bf16_t* Bt, int K, int Npad, LAS float* tile) {
    const int tid = tid_opaque(), ntn = Npad / 64, ntk = K / 64, ntile = ntn * ntk;
    LAS float* tileB = tile + 64 * 65;
    for (int t = blockIdx.x; t < ntile; t += 2 * gridDim.x) {
        const int t1 = t + gridDim.x; const bool has1 = t1 < ntile;
        const int tn0 = t % ntn, tk0 = t / ntn, tn1 = has1 ? t1 % ntn : tn0, tk1 = has1 ? t1 / ntn : tk0;
        { const int j = tid & 63, i0 = tid >> 6; const int n0 = tn0 * 64 + j, n1 = tn1 * 64 + j; const int s0 = MAP == 1 ? win_src_col(n0) : (MAP == 2 ? up_src_col(n0) : n0), s1 = MAP == 1 ? win_src_col(n1) : (MAP == 2 ? up_src_col(n1) : n1);
            float a[8], b[8];
#pragma unroll
            for (int q = 0; q < 8; ++q) { const int i = i0 + 8 * q; a[q] = s0 >= 0 ? W[(size_t)(tk0 * 64 + i) * ldw + s0] : 0.f; b[q] = (has1 && s1 >= 0) ? W[(size_t)(tk1 * 64 + i) * ldw + s1] : 0.f; }
#pragma unroll
            for (int q = 0; q < 8; ++q) { const int i = i0 + 8 * q; tile[j * 65 + i] = a[q]; tileB[j * 65 + i] = b[q]; } }
        __syncthreads();
        { const int nl = tid >> 3, kc = (tid & 7) * 8;
            { LAS const float* tp = tile + nl * 65 + kc; u32x4 w; w.x = cvt_pk_bf16(tp[0], tp[1]); w.y = cvt_pk_bf16(tp[2], tp[3]); w.z = cvt_pk_bf16(tp[4], tp[5]); w.w = cvt_pk_bf16(tp[6], tp[7]);
              *(u32x4*)(Bt + (size_t)(tn0 * 64 + nl) * K + tk0 * 64 + kc) = w; }
            if (has1) { LAS const float* tp = tileB + nl * 65 + kc; u32x4 w; w.x = cvt_pk_bf16(tp[0], tp[1]); w.y = cvt_pk_bf16(tp[2], tp[3]); w.z = cvt_pk_bf16(tp[4], tp[5]); w.w = cvt_pk_bf16(tp[6], tp[7]);
              *(u32x4*)(Bt + (size_t)(tn1 * 64 + nl) * K + tk1 * 64 + kc) = w; } }
        __syncthreads();
    }
}
__device__ __forceinline__ void phase_weights(const Params& p, int l, LAS unsigned char* lds) {
    LAS float* tile = (LAS float*)lds; unsigned char* ws = p.ws + (size_t)l * WL;
    convT<1>(p.w_in + (size_t)l * 1024 * INC, INC, (bf16_t*)(ws + W_IN), 1024, NP1, tile);
    convT<0>(p.w_branch + (size_t)l * 3 * 512 * 1024, 1024, (bf16_t*)(ws + W_BR), 1536, 1024, tile);
    convT<0>(p.w_out + (size_t)l * 1024 * 1024, 1024, (bf16_t*)(ws + W_OUT), 1024, 1024, tile);
    convT<2>(p.w_up + (size_t)l * 1024 * NUP, NUP, (bf16_t*)(ws + W_UP), 1024, NUP, tile);
    convT<0>(p.w_down + (size_t)l * DFF * 1024, 1024, (bf16_t*)(ws + W_DN), DFF, 1024, tile);
    if (l == 0) {
        const float invf[8] = {1.0f, 0.1939227432012558f, 0.03760603070259094f, 0.007292664609849453f, 0.0014142135623842478f, 0.00027424818836152554f, 5.318296098266728e-05f, 1.0313386155758053e-05f};
        float2* rot = (float2*)(p.ws + OFF_ROT);
        for (int e = blockIdx.x * 512 + tid_opaque(); e < SEQ * 8; e += gridDim.x * 512) {
            const int i = e & 7, pos = e >> 3; float fi = invf[0];
#pragma unroll
            for (int k = 1; k < 8; ++k) fi = (i == k) ? invf[k] : fi;
            const float ang = (float)pos * fi; const double a = (double)ang;
            const double kk = rint(a * 0.15915494309189535); const double r = fma(-kk, 6.283185307179586, a);
            const double r2 = r * r; double s = 1.0, c = 1.0;
#pragma unroll
            for (int k = 14; k >= 1; --k) { s = 1.0 - s * r2 / (double)((2 * k) * (2 * k + 1)); c = 1.0 - c * r2 / (double)((2 * k - 1) * (2 * k)); }
            rot[e] = make_float2((float)c, (float)(s * r));
        }
    }
}
__device__ __forceinline__ void phase_xb(const float* x, bf16_t* xb, int Tg, int wgi = -1, int nwg = 0) {
    const size_t n8 = (size_t)Tg * 1024 / 8;
    if (wgi < 0) { wgi = blockIdx.x; nwg = gridDim.x; }
    for (size_t i = (size_t)wgi * 512 + tid_opaque(); i < n8; i += (size_t)nwg * 512) {
        const f32x4 a = *(const f32x4*)(x + i * 8), b = *(const f32x4*)(x + i * 8 + 4); *(u32x4*)(xb + i * 8) = pack8(a, b); }
}
__device__ __forceinline__ void phase_cache(const Params& p, int l) {
    bf16_t* kb = (bf16_t*)(p.ws + S_KB); bf16_t* vb = (bf16_t*)(p.ws + S_VB); bf16_t* kib = (bf16_t*)(p.ws + S_KIB);
    const int n1 = DB * PAST * 16, n2 = DB * PAST * 8;
    for (int i = blockIdx.x * 512 + tid_opaque(); i < 2 * n1 + n2; i += gridDim.x * 512) {
        const float* src; bf16_t* dst; int e, w;
        if (i < n1) { e = i; w = 16; src = p.cache_k + (size_t)l * DB * PAST * 128; dst = kb; } else if (i < 2 * n1) { e = i - n1; w = 16; src = p.cache_v + (size_t)l * DB * PAST * 128; dst = vb; }
        else { e = i - 2 * n1; w = 8; src = p.cache_ik + (size_t)l * DB * PAST * 64; dst = kib; }
        const int rowi = e / w, cg8 = e % w, b = rowi / PAST, j = rowi % PAST;
        const float* s = src + ((size_t)rowi * w + cg8) * 8; const f32x4 a = *(const f32x4*)s, c = *(const f32x4*)(s + 4);
        *(u32x4*)(dst + ((size_t)(b * LCAT + j) * w + cg8) * 8) = pack8(a, c);
    }
}

__device__ __forceinline__ void phase_ln(float* x, bf16_t* xb, const float* g, const float* b, int Tg) {
    const int tid_ = tid_opaque(); const int lane = tid_ & 63, w = tid_ >> 6;
    const int stride = gridDim.x * 8;
    for (int row0 = blockIdx.x * 8 + w; row0 < Tg; row0 += 2 * stride) {
        const int row1 = row0 + stride; const bool has1 = row1 < Tg;
        f32x4 v[2][4];
#pragma unroll
        for (int i = 0; i < 4; ++i) { v[0][i] = *(const f32x4*)(x + (size_t)row0 * 1024 + i * 256 + lane * 4); v[1][i] = has1 ? *(const f32x4*)(x + (size_t)row1 * 1024 + i * 256 + lane * 4) : (f32x4){0.f, 0.f, 0.f, 0.f}; }
#pragma unroll
        for (int rr = 0; rr < 2; ++rr) {
            if (rr == 1 && !has1) break;
            const int row = rr ? row1 : row0; float* xr = x + (size_t)row * 1024; float s = 0.f;
#pragma unroll
            for (int i = 0; i < 4; ++i) s += (v[rr][i][0] + v[rr][i][1]) + (v[rr][i][2] + v[rr][i][3]);
#pragma unroll
            for (int o = 32; o >= 1; o >>= 1) s += __shfl_xor(s, o);
            const float mu = s * (1.f / 1024.f); float q = 0.f;
#pragma unroll
            for (int i = 0; i < 4; ++i) { v[rr][i] -= mu; q += (v[rr][i][0] * v[rr][i][0] + v[rr][i][1] * v[rr][i][1]) + (v[rr][i][2] * v[rr][i][2] + v[rr][i][3] * v[rr][i][3]); }
#pragma unroll
            for (int o = 32; o >= 1; o >>= 1) q += __shfl_xor(q, o);
            const float rstd = rsqrtf(q * (1.f / 1024.f) + LN_EPS);
#pragma unroll
            for (int i = 0; i < 4; ++i) { const int c = i * 256 + lane * 4; const f32x4 gg = *(const f32x4*)(g + c), bb = *(const f32x4*)(b + c);
                const f32x4 y = v[rr][i] * rstd * gg + bb; *(f32x4*)(xr + c) = y;
                if (xb) { u32x2 w2; w2.x = cvt_pk_bf16(y[0], y[1]); w2.y = cvt_pk_bf16(y[2], y[3]); *(u32x2*)(xb + (size_t)row * 1024 + c) = w2; } }
        }
    }
}

__device__ __forceinline__ void phase_ffnconv(const Params& p, int l, const GroupCtx& gc, const bf16_t* __restrict__ h, bf16_t* __restrict__ gout) {
    const float* cw = p.ffn_cw + (size_t)l * 3 * NUP; const float* cbias = p.ffn_cb + (size_t)l * NUP;
    const float* hist = p.state_ffn + (size_t)l * DB * 2 * NUP;
    constexpr int NCG = DFF / 8, RB = 32; const int total = (gc.Tg / RB) * NCG;
    for (int e = blockIdx.x * 512 + tid_opaque(); e < total; e += gridDim.x * 512) {
        const int cg8 = (e % NCG) * 8, row0 = (e / NCG) * RB;
        int sp0, bidx; if (gc.sample) { sp0 = row0 & 63; bidx = row0 >> 6; } else { sp0 = (gc.gbaseT + row0) & (SEQ - 1); bidx = 0; }
        float w0[2][8], w1[2][8], w2[2][8], bs[2][8], p2[2][8], p1[2][8];
#pragma unroll
        for (int hf = 0; hf < 2; ++hf) {
            const int cc = cg8 + hf * DFF;
#pragma unroll
            for (int j = 0; j < 8; ++j) { w0[hf][j] = cw[cc + j]; w1[hf][j] = cw[NUP + cc + j]; w2[hf][j] = cw[2 * NUP + cc + j]; bs[hf][j] = cbias[cc + j]; }
            if (sp0 >= 2) { unpack8(*(const u32x4*)(h + (size_t)(row0 - 2) * NUP + cc), p2[hf]); unpack8(*(const u32x4*)(h + (size_t)(row0 - 1) * NUP + cc), p1[hf]); }
            else if (gc.sample) {
#pragma unroll
                for (int j = 0; j < 8; ++j) { p2[hf][j] = hist[(size_t)(bidx * 2 + 0) * NUP + cc + j]; p1[hf][j] = hist[(size_t)(bidx * 2 + 1) * NUP + cc + j]; } }
            else {
#pragma unroll
                for (int j = 0; j < 8; ++j) { p2[hf][j] = 0.f; p1[hf][j] = 0.f; } }
        }
#pragma unroll 4
        for (int r = 0; r < RB; ++r) {
            const bf16_t* hp = h + (size_t)(row0 + r) * NUP + cg8;
            float ca[8], cb2[8]; unpack8(*(const u32x4*)hp, ca); unpack8(*(const u32x4*)(hp + DFF), cb2);
            float oa[8], ob[8];
#pragma unroll
            for (int j = 0; j < 8; ++j) {
                oa[j] = bs[0][j] + w0[0][j] * p2[0][j] + w1[0][j] * p1[0][j] + w2[0][j] * ca[j];
                ob[j] = bs[1][j] + w0[1][j] * p2[1][j] + w1[1][j] * p1[1][j] + w2[1][j] * cb2[j];
                p2[0][j] = p1[0][j]; p1[0][j] = ca[j]; p2[1][j] = p1[1][j]; p1[1][j] = cb2[j];
            }
            u32x4 wv;
            wv.x = cvt_pk_bf16(fsilu(oa[0]) * ob[0], fsilu(oa[1]) * ob[1]); wv.y = cvt_pk_bf16(fsilu(oa[2]) * ob[2], fsilu(oa[3]) * ob[3]);
            wv.z = cvt_pk_bf16(fsilu(oa[4]) * ob[4], fsilu(oa[5]) * ob[5]); wv.w = cvt_pk_bf16(fsilu(oa[6]) * ob[6], fsilu(oa[7]) * ob[7]);
            *(u32x4*)(gout + (size_t)(row0 + r) * DFF + cg8) = wv;
        }
    }
}

__device__ __forceinline__ void phase_sconv(const Params& p, int l, const GroupCtx& gc, const bf16_t* cb, const bf16_t* u, bf16_t* yc) {
    const float* cw = p.sconv_w + (size_t)l * 3 * 512; const float* cbias = p.sconv_b + (size_t)l * 512;
    const float* hist = p.state_sconv + (size_t)l * DB * 2 * 512;
    const size_t total = (size_t)gc.Tg * 64;
    for (size_t e = (size_t)blockIdx.x * 512 + tid_opaque(); e < total; e += (size_t)gridDim.x * 512) {
        const int row = (int)(e >> 6), c = (int)(e & 63) * 8;
        int sp, bidx; if (gc.sample) { sp = row & 63; bidx = row >> 6; } else { sp = (gc.gbaseT + row) & (SEQ - 1); bidx = 0; }
        float a[8];
#pragma unroll
        for (int j = 0; j < 8; ++j) a[j] = cbias[c + j];
#pragma unroll
        for (int k = 0; k < 3; ++k) {
            const int sr = sp - 2 + k; float hv[8];
            if (sr >= 0) { unpack8(*(const u32x4*)(u + (size_t)(row - 2 + k) * 512 + c), hv); }
            else if (gc.sample) { const float* hp = hist + (size_t)(bidx * 2 + (sr + 2)) * 512 + c;
#pragma unroll
                for (int j = 0; j < 8; ++j) hv[j] = hp[j]; }
            else {
#pragma unroll
                for (int j = 0; j < 8; ++j) hv[j] = 0.f; }
#pragma unroll
            for (int j = 0; j < 8; ++j) a[j] += cw[k * 512 + c + j] * hv[j];
        }
        float cv[8]; unpack8(*(const u32x4*)(cb + (size_t)row * 512 + c), cv);
        u32x4 w; w.x = cvt_pk_bf16(cv[0] * a[0], cv[1] * a[1]); w.y = cvt_pk_bf16(cv[2] * a[2], cv[3] * a[3]); w.z = cvt_pk_bf16(cv[4] * a[4], cv[5] * a[5]); w.w = cvt_pk_bf16(cv[6] * a[6], cv[7] * a[7]);
        *(u32x4*)(yc + (size_t)row * 1536 + c) = w;
    }
}

typedef unsigned short u16x2 __attribute__((ext_vector_type(2)));
__device__ __forceinline__ int sc_pos(int j) { return (((j >> 7) * 64 + (j & 63)) << 1) | ((j >> 6) & 1); }
__device__ __forceinline__ int wave_sum(int v) {
    v += __builtin_amdgcn_update_dpp(0, v, 0x128, 0xf, 0xf, false);
    v += __builtin_amdgcn_update_dpp(0, v, 0x124, 0xf, 0xf, false);
    v += __builtin_amdgcn_update_dpp(0, v, 0x122, 0xf, 0xf, false);
    v += __builtin_amdgcn_update_dpp(0, v, 0x121, 0xf, 0xf, false);
    return (__builtin_amdgcn_readlane(v, 0) + __builtin_amdgcn_readlane(v, 16)) + (__builtin_amdgcn_readlane(v, 32) + __builtin_amdgcn_readlane(v, 48));
}
template <int J, unsigned M> __device__ __forceinline__ void tstage32(unsigned (&A)[32]) {
#pragma unroll
    for (int k = 0; k < 32; ++k) if ((k & J) == 0) { const unsigned a = A[k], b = A[k + J]; A[k] = (a & M) | ((b << J) & ~M); A[k + J] = ((a >> J) & M) | (b & ~M); }
}
__device__ __forceinline__ void transpose32(unsigned (&A)[32]) {
    tstage32<16, 0x0000FFFFu>(A); tstage32<8, 0x00FF00FFu>(A); tstage32<4, 0x0F0F0F0Fu>(A); tstage32<2, 0x33333333u>(A); tstage32<1, 0x55555555u>(A);
}
template <int R2>
__device__ __forceinline__ int select_topk(LAS const unsigned* rowp, LAS unsigned short* list, int ntarget, int nk, int lane) {
    constexpr int NBLK = (R2 + 31) / 32;
    unsigned W[NBLK][32];
#pragma unroll
    for (int blk = 0; blk < NBLK; ++blk) {
#pragma unroll
        for (int c = 0; c < 32; ++c) { const int r = blk * 32 + c; W[blk][c] = (r < R2) ? rowp[r * 64 + lane] : 0u; }
        transpose32(W[blk]);
#pragma unroll
        for (int h = 0; h < 2; ++h) { const unsigned sg = W[blk][16 * h + 15];
#pragma unroll
            for (int b = 0; b < 15; ++b) W[blk][16 * h + b] ^= sg;
            W[blk][16 * h + 15] = ~sg; }
    }
    const int nr = nk >> 6;
    unsigned alive[NBLK][2], sel[NBLK][2];
#pragma unroll
    for (int blk = 0; blk < NBLK; ++blk)
#pragma unroll
        for (int h = 0; h < 2; ++h) { const int t = nr - blk * 64 - h + 1; int nj = t <= 0 ? 0 : (t >> 1); nj = nj > 32 ? 32 : nj;
            alive[blk][h] = nj >= 32 ? 0xffffffffu : ((1u << nj) - 1u); sel[blk][h] = 0u; }
    int need = ntarget; bool done = false;
#pragma unroll
    for (int b = 15; b >= 0; --b) if (!done) {
        unsigned ones[NBLK][2]; int c = 0;
#pragma unroll
        for (int blk = 0; blk < NBLK; ++blk)
#pragma unroll
            for (int h = 0; h < 2; ++h) { ones[blk][h] = alive[blk][h] & W[blk][16 * h + b]; c += __popc(ones[blk][h]); }
        c = wave_sum(c);
        if (c >= need) {
#pragma unroll
            for (int blk = 0; blk < NBLK; ++blk)
#pragma unroll
                for (int h = 0; h < 2; ++h) alive[blk][h] = ones[blk][h];
            if (c == need) {
#pragma unroll
                for (int blk = 0; blk < NBLK; ++blk)
#pragma unroll
                    for (int h = 0; h < 2; ++h) { sel[blk][h] |= alive[blk][h]; alive[blk][h] = 0u; }
                need = 0; done = true;
            }
        } else {
            need -= c;
#pragma unroll
            for (int blk = 0; blk < NBLK; ++blk)
#pragma unroll
                for (int h = 0; h < 2; ++h) { sel[blk][h] |= ones[blk][h]; alive[blk][h] ^= ones[blk][h]; }
        }
    }
    if (need > 0) {
        int ca = 0;
#pragma unroll
        for (int blk = 0; blk < NBLK; ++blk)
#pragma unroll
            for (int h = 0; h < 2; ++h) ca += __popc(alive[blk][h]);
        ca = wave_sum(ca);
        if (ca == need) {
#pragma unroll
            for (int blk = 0; blk < NBLK; ++blk)
#pragma unroll
                for (int h = 0; h < 2; ++h) sel[blk][h] |= alive[blk][h];
        } else {
#pragma unroll
            for (int blk = 0; blk < NBLK; ++blk)
                for (int j = 0; j < 32; ++j)
#pragma unroll
                    for (int h = 0; h < 2; ++h) {
                        const bool bit = ((alive[blk][h] >> j) & 1u) != 0u; const unsigned long long m = __ballot(bit);
                        if (bit && mbcnt64(m) < need) sel[blk][h] |= 1u << j;
                        const int cnt = __popcll(m); need -= cnt < need ? cnt : need;
                    }
        }
    }
    int n = 0;
#pragma unroll
    for (int blk = 0; blk < NBLK; ++blk)
#pragma unroll
        for (int h = 0; h < 2; ++h) n += __popc(sel[blk][h]);
    int incl = n;
#pragma unroll
    for (int o = 1; o < 64; o <<= 1) { const int t = __shfl_up(incl, o); if (lane >= o) incl += t; }
    int pos = incl - n;
#pragma unroll
    for (int blk = 0; blk < NBLK; ++blk)
#pragma unroll
        for (int h = 0; h < 2; ++h) { unsigned m = sel[blk][h];
            while (m) { const int j = __builtin_ctz(m); m &= m - 1u; list[pos] = (unsigned short)((blk * 64 + 2 * j + h) * 64 + lane); ++pos; } }
    return ntarget;
}
struct AttnArgs { unsigned char* ws; GroupCtx gc; };
__device__ __forceinline__ void attn_item(const AttnArgs& a, int item, LAS unsigned char* lds) {
    const int tid = tid_opaque(), w = tid >> 6, lane = tid & 63, g = lane >> 4, c16 = lane & 15;
    const bf16_t* const aq = (const bf16_t*)AX(a.gc, A_Q); const bf16_t* const aqi = (const bf16_t*)AX(a.gc, A_QI); const bf16_t* const akb = (const bf16_t*)a.gc.kb; const bf16_t* const avb = (const bf16_t*)a.gc.vb;
    const bf16_t* const akib = (const bf16_t*)a.gc.kib; const float* const aiw = (const float*)AX(a.gc, A_IW); bf16_t* const aya = (bf16_t*)AX(a.gc, A_YA);
    int qrow0, krow0, nk;
    if (a.gc.sample) { qrow0 = item * 8; krow0 = (qrow0 >> 6) * LCAT; nk = LCAT; }
    else { const int c = 127 - (item >> 4), bl = (item >> 3) & 1, sub = item & 7; qrow0 = bl * SEQ + c * 64 + sub * 8; krow0 = bl * SEQ; nk = 64 * (c + 1); }
    const int R = nk <= 2048 ? 32 : (nk <= 4096 ? 64 : 128);
    LAS unsigned short* sc = (LAS unsigned short*)lds;
    LAS unsigned short* listall = (LAS unsigned short*)(lds + 131072);
    LAS float* invs = (LAS float*)(lds + 131072 + 4096);
    __syncthreads();
    {
        bf16x8 qa[2][2]; f32x4 iwv[2];
#pragma unroll
        for (int mb = 0; mb < 2; ++mb) {
            const int qr = qrow0 + 4 * mb + (c16 >> 2), h = c16 & 3;
#pragma unroll
            for (int kh = 0; kh < 2; ++kh) qa[mb][kh] = *(const bf16x8*)(aqi + (size_t)qr * 256 + h * 64 + kh * 32 + g * 8);
            iwv[mb] = *(const f32x4*)(aiw + (size_t)(qrow0 + 4 * mb + g) * 4);
        }
        const int ntile = nk >> 4;
        for (int kt0 = w; kt0 < ntile; kt0 += 64) {
            bf16x8 b0[8], b1[8];
#pragma unroll
            for (int i = 0; i < 8; ++i) { const int kt = kt0 + 8 * i; if (kt < ntile) { const bf16_t* kp = akib + (size_t)(krow0 + kt * 16 + c16) * 64 + g * 8; b0[i] = *(const bf16x8*)kp; b1[i] = *(const bf16x8*)(kp + 32); } }
#pragma unroll
            for (int i = 0; i < 8; ++i) { const int kt = kt0 + 8 * i; if (kt < ntile) { const int key = kt * 16 + c16;
#pragma unroll
                for (int mb = 0; mb < 2; ++mb) {
                    f32x4 d = (f32x4){0.f, 0.f, 0.f, 0.f}; d = MFMA16(qa[mb][0], b0[i], d); d = MFMA16(qa[mb][1], b1[i], d);
                    float s = 0.f;
#pragma unroll
                    for (int j = 0; j < 4; ++j) s += iwv[mb][j] * fmaxf(d[j], 0.f);
                    const unsigned hb = (unsigned)__half_as_ushort(__float2half_rn(s));
                    sc[(4 * mb + g) * 8192 + sc_pos(key)] = (unsigned short)hb;
                } } }
        }
    }
    __syncthreads();
    LAS unsigned short* list = listall + w * 256;
    const int ntarget = nk < 256 ? nk : 256;
    int nsel;
    { LAS const unsigned* rp = (LAS const unsigned*)(sc + w * 8192);
      if (R == 32) nsel = select_topk<16>(rp, list, ntarget, nk, lane); else if (R == 64) nsel = select_topk<32>(rp, list, ntarget, nk, lane); else nsel = select_topk<64>(rp, list, ntarget, nk, lane); }
    asm volatile("s_waitcnt lgkmcnt(0)" ::: "memory");
    const int qr = qrow0 + w;
    LAS float* pbuf = (LAS float*)(sc + w * 8192);
    const int ksub = lane >> 4, kvh = c16 >> 3;
    const bf16_t* vbase = avb + (size_t)krow0 * 128 + c16 * 8;
    u32x4 vA[8];
    {
        bf16x8 qb[4];
#pragma unroll
        for (int ks = 0; ks < 4; ++ks) {
            const bool valid = (c16 < 8) && ((c16 >> 2) == (ks >> 1));
            bf16x8 z = {0, 0, 0, 0, 0, 0, 0, 0};
            qb[ks] = valid ? *(const bf16x8*)(aq + (size_t)qr * 512 + c16 * 64 + (ks & 1) * 32 + g * 8) : z;
        }
        const int ntile = nsel >> 4;
        f32x4 lg[16];
#pragma unroll
        for (int t = 0; t < 16; ++t) {
            lg[t] = (f32x4){-1e30f, -1e30f, -1e30f, -1e30f};
            if (t < ntile) {
                const int idx = list[t * 16 + c16]; const bf16_t* kp = akb + (size_t)(krow0 + idx) * 128 + g * 8;
                f32x4 d = (f32x4){0.f, 0.f, 0.f, 0.f};
#pragma unroll
                for (int ks = 0; ks < 4; ++ks) d = MFMA16(*(const bf16x8*)(kp + ks * 32), qb[ks], d);
                lg[t] = d;
            }
        }
#pragma unroll
        for (int i = 0; i < 8; ++i) { const int idx = list[4 * i + ksub]; vA[i] = *(const u32x4*)(vbase + (size_t)idx * 128); }
        float mx = -1e30f;
#pragma unroll
        for (int t = 0; t < 16; ++t) mx = fmaxf(mx, fmaxf(fmaxf(lg[t][0], lg[t][1]), fmaxf(lg[t][2], lg[t][3])));
        mx = fmaxf(mx, __shfl_xor(mx, 16)); mx = fmaxf(mx, __shfl_xor(mx, 32));
        float sum = 0.f;
#pragma unroll
        for (int t = 0; t < 16; ++t) {
            if (t < ntile) {
#pragma unroll
                for (int j = 0; j < 4; ++j) { const float pv = __expf(lg[t][j] - mx); sum += pv; if (c16 < 8) pbuf[(t * 16 + 4 * g + j) * 8 + c16] = pv; }
            }
        }
        sum += __shfl_xor(sum, 16); sum += __shfl_xor(sum, 32);
        if (c16 < 8 && g == 0) invs[w * 8 + c16] = 1.0f / sum;
    }
    asm volatile("s_waitcnt lgkmcnt(0)" ::: "memory");
    {
        typedef float f32x2 __attribute__((ext_vector_type(2)));
        f32x2 o2[4][4];
#pragma unroll
        for (int hh = 0; hh < 4; ++hh)
#pragma unroll
            for (int d = 0; d < 4; ++d) o2[hh][d] = (f32x2){0.f, 0.f};
        auto pv_acc = [&](const u32x4 (&vv)[8], int nb) {
#pragma unroll
            for (int i = 0; i < 8; ++i) {
                const f32x4 p4 = *(const LAS f32x4*)(pbuf + (nb + 4 * i + ksub) * 8 + kvh * 4);
                f32x2 v2[4]; v2[0] = (f32x2){bflo(vv[i].x), bfhi(vv[i].x)}; v2[1] = (f32x2){bflo(vv[i].y), bfhi(vv[i].y)}; v2[2] = (f32x2){bflo(vv[i].z), bfhi(vv[i].z)}; v2[3] = (f32x2){bflo(vv[i].w), bfhi(vv[i].w)};
#pragma unroll
                for (int hh = 0; hh < 4; ++hh) { const f32x2 pp = (f32x2){p4[hh], p4[hh]};
#pragma unroll
                    for (int d = 0; d < 4; ++d) o2[hh][d] = __builtin_elementwise_fma(pp, v2[d], o2[hh][d]); }
            }
        };
        for (int n0 = 0; n0 < nsel; n0 += 64) {
            u32x4 vB[8];
#pragma unroll
            for (int i = 0; i < 8; ++i) { const int idx = list[n0 + 32 + 4 * i + ksub]; vB[i] = *(const u32x4*)(vbase + (size_t)idx * 128); }
            pv_acc(vA, n0);
            if (n0 + 64 < nsel) {
#pragma unroll
                for (int i = 0; i < 8; ++i) { const int idx = list[n0 + 64 + 4 * i + ksub]; vA[i] = *(const u32x4*)(vbase + (size_t)idx * 128); }
            }
            pv_acc(vB, n0 + 32);
        }
        float o[4][8];
#pragma unroll
        for (int hh = 0; hh < 4; ++hh)
#pragma unroll
            for (int d = 0; d < 4; ++d) { float a0 = o2[hh][d].x, a1 = o2[hh][d].y;
                a0 += __shfl_xor(a0, 16); a0 += __shfl_xor(a0, 32); a1 += __shfl_xor(a1, 16); a1 += __shfl_xor(a1, 32); o[hh][2 * d] = a0; o[hh][2 * d + 1] = a1; }
        if (ksub == 0) {
#pragma unroll
            for (int hh = 0; hh < 4; ++hh) { const int h = kvh * 4 + hh; const float inv = invs[w * 8 + h];
                u32x4 wv; wv.x = cvt_pk_bf16(o[hh][0] * inv, o[hh][1] * inv); wv.y = cvt_pk_bf16(o[hh][2] * inv, o[hh][3] * inv); wv.z = cvt_pk_bf16(o[hh][4] * inv, o[hh][5] * inv); wv.w = cvt_pk_bf16(o[hh][6] * inv, o[hh][7] * inv);
                *(u32x4*)(aya + (size_t)qr * 1536 + h * 64 + (c16 & 7) * 8) = wv; }
        }
    }
}

struct HgrnArgs { unsigned char* ws; const float* ng; GroupCtx gc; };
#define HG_PTRS const bf16_t* const hq_ = (const bf16_t*)AX(a.gc, A_HQ); const bf16_t* const lf_ = (const bf16_t*)AX(a.gc, A_LF); const bf16_t* const kh_ = (const bf16_t*)AX(a.gc, A_KH); const bf16_t* const hv_ = (const bf16_t*)AX(a.gc, A_HV); \
    const bf16_t* const hg_ = (const bf16_t*)AX(a.gc, A_HG); bf16_t* const st_p = (bf16_t*)AX(a.gc, A_ST); float* const dec_ = (float*)AX(a.gc, A_DEC); bf16_t* const yb_ = (bf16_t*)AX(a.gc, A_YA) + 512;
__device__ __forceinline__ void hgrn_item(const GroupCtx& gc, int item, int& bh, int& ch, int& r0, int& hb) {
    if (gc.sample) { bh = item; ch = 0; r0 = (item >> 2) * 64; hb = (item & 3) * 128; }
    else { bh = item >> 7; ch = item & 127; r0 = (bh >> 2) * SEQ + ch * 64; hb = (bh & 3) * 128; }
}
__device__ __forceinline__ void hgrn_cum(const bf16_t* lf, int r0, int hb, int p, int dk, LAS float* tot, float (&c)[16], float& last, float& mid) {
    float s = 0.f;
#pragma unroll
    for (int i = 0; i < 16; ++i) { s += bf2f(lf[(size_t)(r0 + p * 16 + i) * 512 + hb + dk]); c[i] = s; }
    tot[p * 128 + dk] = s;
    __syncthreads();
    const float t0 = tot[dk], t1 = tot[128 + dk], t2 = tot[256 + dk], t3 = tot[384 + dk];
    const float off = (p > 0 ? t0 : 0.f) + (p > 1 ? t1 : 0.f) + (p > 2 ? t2 : 0.f);
#pragma unroll
    for (int i = 0; i < 16; ++i) c[i] += off;
    last = (t0 + t1) + (t2 + t3); mid = t0 + t1;
}
constexpr int LDQ = 136, LDS_ = 72;
__device__ __forceinline__ void hgrn_pass1(const HgrnArgs& a, int item, LAS unsigned char* lds) {
    const int tid = tid_opaque(), w = tid >> 6, lane = tid & 63, g = lane >> 4, c16 = lane & 15, p = tid >> 7, dk = tid & 127;
    int bh, ch, r0, hb; hgrn_item(a.gc, item, bh, ch, r0, hb); HG_PTRS
    LAS bf16_t* KT = (LAS bf16_t*)lds;
    LAS bf16_t* VT = (LAS bf16_t*)(lds + 128 * LDS_ * 2);
    LAS float* tot = (LAS float*)(lds + 2 * 128 * LDS_ * 2);
    __syncthreads();
    unsigned short kraw[16], vraw[16];
#pragma unroll
    for (int i = 0; i < 16; ++i) { const size_t o0 = (size_t)(r0 + p * 16 + i) * 512 + hb + dk; kraw[i] = kh_[o0]; vraw[i] = hv_[o0]; }
    float c[16], last, mid; hgrn_cum(lf_, r0, hb, p, dk, tot, c, last, mid);
    {
        unsigned kw[8], vw[8];
#pragma unroll
        for (int i = 0; i < 16; i += 2) {
            const float k0 = bf2f(kraw[i]) * __expf(last - c[i]), k1 = bf2f(kraw[i + 1]) * __expf(last - c[i + 1]);
            kw[i >> 1] = cvt_pk_bf16(k0, k1); vw[i >> 1] = (unsigned)vraw[i] | ((unsigned)vraw[i + 1] << 16);
        }
        LAS u32x4* kd = (LAS u32x4*)(KT + dk * LDS_ + p * 16); kd[0] = (u32x4){kw[0], kw[1], kw[2], kw[3]}; kd[1] = (u32x4){kw[4], kw[5], kw[6], kw[7]};
        LAS u32x4* vd = (LAS u32x4*)(VT + dk * LDS_ + p * 16); vd[0] = (u32x4){vw[0], vw[1], vw[2], vw[3]}; vd[1] = (u32x4){vw[4], vw[5], vw[6], vw[7]};
        if (p == 3) dec_[(size_t)(bh * (a.gc.sample ? 1 : 128) + ch) * 128 + dk] = __expf(last);
    }
    __syncthreads();
    {
        bf16x8 ka[2];
#pragma unroll
        for (int ks = 0; ks < 2; ++ks) ka[ks] = *(const LAS bf16x8*)(KT + (w * 16 + c16) * LDS_ + ks * 32 + g * 8);
        bf16_t* stp = st_p + (size_t)(bh * (a.gc.sample ? 1 : 128) + ch) * 16384;
#pragma unroll
        for (int dvt = 0; dvt < 8; ++dvt) {
            f32x4 d = (f32x4){0.f, 0.f, 0.f, 0.f};
#pragma unroll
            for (int ks = 0; ks < 2; ++ks) d = MFMA16(ka[ks], *(const LAS bf16x8*)(VT + (dvt * 16 + c16) * LDS_ + ks * 32 + g * 8), d);
            u32x2 wv; wv.x = cvt_pk_bf16(d[0], d[1]); wv.y = cvt_pk_bf16(d[2], d[3]);
            *(u32x2*)(stp + (size_t)(dvt * 16 + c16) * 128 + w * 16 + 4 * g) = wv;
        }
    }
}
__device__ __forceinline__ void hgrn_scan(const Params& p, int l, const GroupCtx& gc, bf16_t* __restrict__ st, const float* __restrict__ dec, int gidx, int only_bh) {
    const int nbh = gc.nbat * 4, nch = gc.sample ? 1 : 128; const int nwi = nbh * 64;
    float* outp = p.out + (gc.sample ? O_HS + (size_t)l * DB * 4 * 16384 : O_HP + ((size_t)l * NB + gidx * 2) * 4 * 16384);
    const int tid = tid_opaque(), w = tid >> 6, lane = tid & 63;
    const int wi0 = only_bh >= 0 ? only_bh * 64 + w : (int)blockIdx.x + w * (int)gridDim.x, wi1 = only_bh >= 0 ? only_bh * 64 + 64 : nwi, wis = only_bh >= 0 ? 8 : (int)gridDim.x * 8;
    for (int wi = wi0; wi < wi1; wi += wis) {
        const int bh = wi >> 6, dv = (wi & 63) * 2 + (lane >> 5), dk0 = (lane & 31) * 4;
        float S[4];
#pragma unroll
        for (int j = 0; j < 4; ++j) S[j] = gc.sample ? p.state_hgrn[((size_t)l * DB * 4 + bh) * 16384 + (size_t)(dk0 + j) * 128 + dv] : 0.f;
        bf16_t* sp = st + (size_t)bh * nch * 16384 + dv * 128 + dk0;
        const float* dp = dec + (size_t)bh * nch * 128 + dk0;
        for (int c0 = 0; c0 < nch; c0 += 16) {
            u32x2 U[16]; f32x4 Dv[16];
#pragma unroll
            for (int i = 0; i < 16; ++i) if (c0 + i < nch) { U[i] = *(const u32x2*)(sp + (size_t)(c0 + i) * 16384); Dv[i] = *(const f32x4*)(dp + (size_t)(c0 + i) * 128); }
#pragma unroll
            for (int i = 0; i < 16; ++i) if (c0 + i < nch) {
                u32x2 wv; wv.x = cvt_pk_bf16(S[0], S[1]); wv.y = cvt_pk_bf16(S[2], S[3]);
                *(u32x2*)(sp + (size_t)(c0 + i) * 16384) = wv;
                S[0] = Dv[i][0] * S[0] + bflo(U[i].x); S[1] = Dv[i][1] * S[1] + bfhi(U[i].x); S[2] = Dv[i][2] * S[2] + bflo(U[i].y); S[3] = Dv[i][3] * S[3] + bfhi(U[i].y);
            }
        }
#pragma unroll
        for (int j = 0; j < 4; ++j) outp[(size_t)bh * 16384 + (size_t)(dk0 + j) * 128 + dv] = S[j];
    }
}
__device__ __forceinline__ void hgrn_pass3(const HgrnArgs& a, int item, LAS unsigned char* lds) {
    const int tid = tid_opaque(), w = tid >> 6, lane = tid & 63, g = lane >> 4, c16 = lane & 15, p = tid >> 7, dk = tid & 127;
    int bh, ch, r0, hb; hgrn_item(a.gc, item, bh, ch, r0, hb); HG_PTRS
    LAS bf16_t* QT = (LAS bf16_t*)lds;
    LAS bf16_t* QP = QT + 64 * LDQ;
    LAS bf16_t* KT = QP + 64 * LDQ;
    LAS bf16_t* VT = KT + 64 * LDQ;
    LAS bf16_t* PM = VT + 128 * LDS_;
    LAS float* tot = (LAS float*)(PM + 64 * LDS_);
    LAS float* red = tot + 512;
    __syncthreads();
    unsigned short qraw[16], kraw[16], vraw[16];
#pragma unroll
    for (int i = 0; i < 16; ++i) { const size_t o0 = (size_t)(r0 + p * 16 + i) * 512 + hb + dk; qraw[i] = hq_[o0]; kraw[i] = kh_[o0]; vraw[i] = hv_[o0]; }
    bf16x8 sa[4]; u32x2 gwv[4];
    {   const bf16_t* stp0 = st_p + (size_t)(bh * (a.gc.sample ? 1 : 128) + ch) * 16384 + (size_t)(w * 16 + c16) * 128 + g * 8;
#pragma unroll
        for (int ks = 0; ks < 4; ++ks) sa[ks] = *(const bf16x8*)(stp0 + ks * 32);
#pragma unroll
        for (int tt = 0; tt < 4; ++tt) gwv[tt] = *(const u32x2*)(hg_ + (size_t)(r0 + tt * 16 + c16) * 512 + hb + w * 16 + 4 * g); }
    const f32x4 gn = *(const f32x4*)(a.ng + w * 16 + 4 * g);
    float c[16], last, mid; hgrn_cum(lf_, r0, hb, p, dk, tot, c, last, mid);
    {
        unsigned vw[8];
#pragma unroll
        for (int i = 0; i < 16; ++i) {
            const int s = p * 16 + i;
            const float qv = bf2f(qraw[i]), kv = bf2f(kraw[i]);
            const float e1 = fminf(fmaxf(c[i] - mid, -60.f), 60.f);
            QT[s * LDQ + dk] = f2bf(qv * __expf(e1)); QP[s * LDQ + dk] = f2bf(qv * __expf(c[i])); KT[s * LDQ + dk] = f2bf(kv * __expf(-e1));
            const unsigned vb = vraw[i]; if (i & 1) vw[i >> 1] |= vb << 16; else vw[i >> 1] = vb;
        }
        LAS u32x4* vd = (LAS u32x4*)(VT + dk * LDS_ + p * 16); vd[0] = (u32x4){vw[0], vw[1], vw[2], vw[3]}; vd[1] = (u32x4){vw[4], vw[5], vw[6], vw[7]};
    }
    __syncthreads();
    {
        const int tt = w >> 1;
#pragma unroll
        for (int q = 0; q < 2; ++q) {
            const int st_ = 2 * (w & 1) + q; u32x2 wv = (u32x2){0u, 0u};
            if (st_ <= tt) {
                f32x4 d = (f32x4){0.f, 0.f, 0.f, 0.f};
#pragma unroll
                for (int ks = 0; ks < 4; ++ks) d = MFMA16(*(const LAS bf16x8*)(KT + (st_ * 16 + c16) * LDQ + ks * 32 + g * 8), *(const LAS bf16x8*)(QT + (tt * 16 + c16) * LDQ + ks * 32 + g * 8), d);
                const int t = tt * 16 + c16, s0 = st_ * 16 + 4 * g;
#pragma unroll
                for (int j = 0; j < 4; ++j) d[j] = (s0 + j <= t) ? d[j] : 0.f;
                wv.x = cvt_pk_bf16(d[0], d[1]); wv.y = cvt_pk_bf16(d[2], d[3]);
            }
            *(LAS u32x2*)(PM + (tt * 16 + c16) * LDS_ + st_ * 16 + 4 * g) = wv;
        }
    }
    __syncthreads();
    f32x4 o[4];
    {
        bf16x8 va[2];
#pragma unroll
        for (int ks = 0; ks < 2; ++ks) va[ks] = *(const LAS bf16x8*)(VT + (w * 16 + c16) * LDS_ + ks * 32 + g * 8);
#pragma unroll
        for (int tt = 0; tt < 4; ++tt) {
            f32x4 d = (f32x4){0.f, 0.f, 0.f, 0.f};
#pragma unroll
            for (int ks = 0; ks < 2; ++ks) if (ks <= (tt >> 1)) d = MFMA16(va[ks], *(const LAS bf16x8*)(PM + (tt * 16 + c16) * LDS_ + ks * 32 + g * 8), d);
#pragma unroll
            for (int ks = 0; ks < 4; ++ks) d = MFMA16(sa[ks], *(const LAS bf16x8*)(QP + (tt * 16 + c16) * LDQ + ks * 32 + g * 8), d);
            o[tt] = d;
            float ss = (d[0] * d[0] + d[1] * d[1]) + (d[2] * d[2] + d[3] * d[3]);
            ss += __shfl_xor(ss, 16); ss += __shfl_xor(ss, 32);
            if (g == 0) red[(tt * 16 + c16) * 8 + w] = ss;
        }
    }
    __syncthreads();
    {
        const int dv0 = w * 16 + 4 * g;
#pragma unroll
        for (int tt = 0; tt < 4; ++tt) {
            const int t = tt * 16 + c16; const f32x4 ra = *(const LAS f32x4*)(red + t * 8), rb = *(const LAS f32x4*)(red + t * 8 + 4);
            const float ssum = ((ra[0] + ra[1]) + (ra[2] + ra[3])) + ((rb[0] + rb[1]) + (rb[2] + rb[3]));
            const float rstd = rsqrtf(ssum * (1.f / 128.f) + LN_EPS);
            const size_t oy = (size_t)(r0 + t) * 1536 + hb + dv0; const u32x2 gw = gwv[tt];
            u32x2 wv; wv.x = cvt_pk_bf16(o[tt][0] * rstd * gn[0] * bflo(gw.x), o[tt][1] * rstd * gn[1] * bfhi(gw.x));
            wv.y = cvt_pk_bf16(o[tt][2] * rstd * gn[2] * bflo(gw.y), o[tt][3] * rstd * gn[3] * bfhi(gw.y));
            *(u32x2*)(yb_ + oy) = wv;
        }
    }
}

#define XB_TMO      128
#define XB_XCNT(j)  (256  + 64 * (j))
#define XB_XSUB(j)  (1280 + 64 * (j))
#define XB_XGEN(j)  (2304 + 64 * (j))
#define XB_TOP      3328
#define XB_TOPGEN   3392
#define XCD_BAR_WORDS 3456
#define XB_SPIN_CAP (1u << 22)
__device__ __forceinline__ unsigned xb_ld(unsigned* p)              { return __hip_atomic_load(p, __ATOMIC_RELAXED, __HIP_MEMORY_SCOPE_AGENT); }
__device__ __forceinline__ unsigned xb_add(unsigned* p, unsigned v) { return __hip_atomic_fetch_add(p, v, __ATOMIC_RELAXED, __HIP_MEMORY_SCOPE_AGENT); }
__device__ __forceinline__ unsigned xb_xcc_id() { return (unsigned)__builtin_amdgcn_s_getreg((3 << 11) | 20) & 0xFu; }
#define XB_SPIN(cond, bar) do { unsigned _sp = 0; while (cond) { __builtin_amdgcn_s_sleep(1); \
    if ((++_sp & 255u) == 0u) { if (xb_ld(&(bar)[XB_TMO])) break; if (_sp > XB_SPIN_CAP) { atomicAdd(&(bar)[XB_TMO], 1u); break; } } } } while (0)
struct XcdBarrier { unsigned* bar; unsigned x; volatile LAS unsigned* st; };
__device__ __forceinline__ XcdBarrier xcd_barrier_post(unsigned* bar, volatile LAS unsigned* st) {
    XcdBarrier b; b.bar = bar; b.x = xb_xcc_id(); b.st = st;
    if (threadIdx.x == 0) (void)xb_add(&bar[XB_XCNT(b.x)], 1u);
    return b;
}
__device__ __forceinline__ void xcd_barrier_complete(unsigned* bar, unsigned x, unsigned& nloc, unsigned& nx) {
    const unsigned G = gridDim.x * gridDim.y * gridDim.z;
    unsigned sum, cnt, mine, sp = 0u;
    for (;;) {
        sum = 0u; cnt = 0u; mine = 0u;
#pragma unroll
        for (unsigned j = 0; j < 16; ++j) { const unsigned c = xb_ld(&bar[XB_XCNT(j)]); sum += c; cnt += (c > 0u) ? 1u : 0u; mine = (j == x) ? c : mine; }
        if (sum == G) break;
        __builtin_amdgcn_s_sleep(1);
        if ((++sp & 255u) == 0u) { if (xb_ld(&bar[XB_TMO])) break; if (sp > XB_SPIN_CAP) { atomicAdd(&bar[XB_TMO], 1u); break; } }
    }
    nloc = mine > 0u ? mine : 1u; nx = cnt > 0u ? cnt : 1u;
}
__device__ __forceinline__ void xcd_barrier(const XcdBarrier& b) {
    asm volatile("s_waitcnt vmcnt(0)" ::: "memory");
    __syncthreads();
    if (threadIdx.x == 0) {
        unsigned* bar = b.bar;
        __builtin_amdgcn_s_waitcnt(0);
        unsigned nloc = b.st[0], nx = b.st[1];
        if (nloc == 0u) { xcd_barrier_complete(bar, b.x, nloc, nx); b.st[0] = nloc; b.st[1] = nx; }
        const unsigned old = xb_add(&bar[XB_XSUB(b.x)], 1u);
        const unsigned gen = old / nloc;
        if (old + 1u == (gen + 1u) * nloc) {
            __builtin_amdgcn_fence(__ATOMIC_RELEASE, "agent");
            asm volatile("s_waitcnt vmcnt(0)" ::: "memory");
            const unsigned og = xb_add(&bar[XB_TOP], 1u);
            const unsigned tg = og / nx;
            if (og + 1u == (tg + 1u) * nx) xb_add(&bar[XB_TOPGEN], 1u);
            else XB_SPIN(xb_ld(&bar[XB_TOPGEN]) == tg, bar);
            __builtin_amdgcn_fence(__ATOMIC_ACQUIRE, "agent");
            xb_add(&bar[XB_XGEN(b.x)], 1u);
            asm volatile("s_waitcnt vmcnt(0)" ::: "memory");
        } else {
            XB_SPIN(xb_ld(&bar[XB_XGEN(b.x)]) == gen, bar);
            __builtin_amdgcn_fence(__ATOMIC_ACQUIRE, "agent");
            asm volatile("s_waitcnt vmcnt(0)" ::: "memory");
        }
    }
    __syncthreads();
}

constexpr int NPH_GROUP = 11, NPH = 1 + 4 * NPH_GROUP;
__global__ __launch_bounds__(512, 2) void mega(Params p) {
    extern __shared__ __attribute__((aligned(16))) unsigned char shm[];
    LAS unsigned char* lds = (LAS unsigned char*)shm;
    cg::grid_group grid = cg::this_grid();
    volatile LAS unsigned* xst = (volatile LAS unsigned*)(lds + 160 * 1024 - 16);
    if (threadIdx.x == 0) { xst[0] = 0u; xst[1] = 0u; }
    __syncthreads();
    XcdBarrier xb = xcd_barrier_post((unsigned*)(p.ws + OFF_BAR), xst);
    if (p.pad == 0x7fffffff) grid.sync();
    unsigned char* const ws0 = p.ws;
    int ph = 0;
#define RUN() (ph >= p.lo && ph < p.hi)
#define NEXT() do { ++ph; if (p.coop && ph > p.lo && ph < p.hi) xcd_barrier(xb); } while (0)
    GroupCtx gcS; gcS.sample = 1; gcS.Tg = DB * DS; gcS.gbaseT = 0; gcS.nbat = DB; gcS.Lk = LCAT; gcS.ab = ws0 + SAR; gcS.sh = 5; gcS.kb = ws0 + S_KB; gcS.vb = ws0 + S_VB; gcS.kib = ws0 + S_KIB; gcS.rev = 1;
    if (RUN()) { phase_weights(p, 0, lds); phase_weights(p, 1, lds); phase_xb(p.x_prompt, (bf16_t*)(p.ws + OFF_XB2), TGMAX); phase_xb(p.x_sample, (bf16_t*)AX(gcS, A_XB), DB * DS); phase_cache(p, 0); }
    NEXT();
    for (int l = 0; l < 2; ++l) {
        for (int gi = 0; gi < 2; ++gi) {
            for (int k = 1; k <= 11; ++k) {
                for (int sub = 0; sub < 2; ++sub) {
                    int ll = l, st = k; GroupCtx gc;
                    if (sub == 0) { gc.sample = 0; gc.Tg = TGMAX; gc.gbaseT = gi * TGMAX; gc.nbat = 2; gc.Lk = SEQ; gc.ab = ws0 + AR; gc.sh = 0; gc.kb = ws0 + A_KB; gc.vb = ws0 + A_VB; gc.kib = ws0 + A_KIB; gc.rev = 0; }
                    else {
                        gc = gcS; st = 0;
                        if (gi == 0) { if (k == 1 && l >= 1) { ll = l - 1; st = 10; } else if (k == 2 && l >= 1) { ll = l - 1; st = 11; } else if ((k == 3 && l >= 1) || (k == 1 && l == 0)) st = 1; else if (k == 4) st = 2; else if (k == 8) st = 5; }
                        else { if (k == 1) st = 6; else if (k == 2) st = 7; else if (k == 8) st = 8; else if (k == 9) st = 9; else if (k == 10 && l == 1) st = 10; else if (k == 11 && l == 1) st = 11; }
                        if (st == 0) continue;
                    }
                    if (!RUN()) continue;
                    __syncthreads();
                    const int Tg = gc.Tg; const int cwg = gc.rev ? (int)gridDim.x - 1 - (int)blockIdx.x : (int)blockIdx.x;
                    unsigned char* ws = sgpr_opaque(ws0);
                    float* yreg = p.out + (gc.sample ? O_YS : O_YP + (size_t)gc.gbaseT * D);
                    const float* xin = (ll == 0) ? (gc.sample ? p.x_sample : p.x_prompt + (size_t)gc.gbaseT * D) : yreg;
                    switch (st) {
                    case 1: {
                        Epi1 E; E.ws = ws; E.out = p.out; E.lbl = p.lb_logits; E.layer = ll; E.gc = gc;
                        Gemm g; g.A = gc.sample ? (const bf16_t*)AX(gc, A_XB) : (const bf16_t*)(ws + OFF_XB2); g.Bt = (const bf16_t*)(ws + (size_t)ll * WL + W_IN); g.K = 1024; g.zA = 0; g.zB = 0;
                        TileOrder S; S.init(Tg, NP1, gridDim.x, cwg, 1);
                        gemm_phase(lds, g, S, E);
                    } break;
                    case 2: {
                        AttnArgs a; a.ws = ws; a.gc = gc;
                        const int nitem = Tg / 8, G = gridDim.x;
                        if (G == 256 && !gc.sample) {
                            const int xcd = (int)blockIdx.x & 7, bl = xcd >> 2, wq = ((int)blockIdx.x >> 3) * 4 + (xcd & 3);
                            for (int r0_ = 0; r0_ < 8; ++r0_) { const int r = (wq & 1) ? 7 - r0_ : r0_;
                                const int i = r * 128 + ((r & 1) ? (127 - wq) : wq); attn_item(a, (i >> 3) * 16 + bl * 8 + (i & 7), lds); }
                        } else if (G == 256 && gc.sample) {
                            if ((int)blockIdx.x < nitem) attn_item(a, ((int)blockIdx.x & 7) * 8 + ((int)blockIdx.x >> 3), lds);
                        } else
                        for (int r = 0; r * G < nitem; ++r) { const int it = r * G + ((r & 1) ? (G - 1 - (int)blockIdx.x) : (int)blockIdx.x); if (it < nitem) attn_item(a, it, lds); }
                        HgrnArgs h; h.ws = ws; h.ng = p.norm_g + (size_t)ll * 128; h.gc = gc;
                        const int nh = gc.sample ? DB * 4 : 2 * 4 * 128;
                        if (gc.sample) {
                            for (int it = cwg; it < nh; it += gridDim.x) { hgrn_pass1(h, it, lds); __syncthreads(); hgrn_scan(p, ll, gc, (bf16_t*)AX(gc, A_ST), (const float*)AX(gc, A_DEC), gi, it); hgrn_pass3(h, it, lds); }
                            phase_sconv(p, ll, gc, (const bf16_t*)AX(gc, A_CB), (const bf16_t*)AX(gc, A_U), (bf16_t*)AX(gc, A_YA) + 1024);
                        } else
                        for (int it = blockIdx.x; it < nh; it += gridDim.x) hgrn_pass1(h, it, lds);
                    } break;
                    case 3: {
                        hgrn_scan(p, ll, gc, (bf16_t*)AX(gc, A_ST), (const float*)AX(gc, A_DEC), gi, -1);
                    } break;
                    case 4: {
                        HgrnArgs h; h.ws = ws; h.ng = p.norm_g + (size_t)ll * 128; h.gc = gc;
                        const int nh = 2 * 4 * 128;
                        for (int it = blockIdx.x; it < nh; it += gridDim.x) hgrn_pass3(h, it, lds);
                        phase_sconv(p, ll, gc, (const bf16_t*)AX(gc, A_CB), (const bf16_t*)AX(gc, A_U), (bf16_t*)AX(gc, A_YA) + 1024);
                    } break;
                    case 5: {
                        EpiMerge E; E.gates = (const bf16_t*)AX(gc, A_GATES); E.merged = (bf16_t*)AX(gc, A_MERGED);
                        Gemm g; g.A = (const bf16_t*)AX(gc, A_YA); g.Bt = (const bf16_t*)(ws + (size_t)ll * WL + W_BR); g.K = 1536; g.zA = 0; g.zB = 0;
                        TileOrder S; S.init(Tg, 1024, gridDim.x, cwg, 1);
                        gemm_phase(lds, g, S, E);
                    } break;
                    case 6: {
                        EpiRes E; E.res = xin; E.dst = (float*)AX(gc, A_X1);
                        Gemm g; g.A = (const bf16_t*)AX(gc, A_MERGED); g.Bt = (const bf16_t*)(ws + (size_t)ll * WL + W_OUT); g.K = 1024; g.zA = 0; g.zB = 0;
                        TileOrder S; S.init(Tg, 1024, gridDim.x, cwg, 1);
                        gemm_phase(lds, g, S, E);
                    } break;
                    case 7: {
                        phase_ln((float*)AX(gc, A_X1), (bf16_t*)AX(gc, A_X1B), p.ln1_g + (size_t)ll * D, p.ln1_b + (size_t)ll * D, Tg);
                    } break;
                    case 8: {
                        EpiUpConv E; E.gout = (bf16_t*)AX(gc, A_G); E.halo = (float*)AX(gc, A_H); E.outff = p.out + (gc.sample ? O_FFS + (size_t)ll * DB * 2 * NUP : O_FFP + (size_t)ll * NB * 2 * NUP);
                        E.cw = p.ffn_cw + (size_t)ll * 3 * NUP; E.cbias = p.ffn_cb + (size_t)ll * NUP; E.gc = gc;
                        Gemm g; g.A = (const bf16_t*)AX(gc, A_X1B); g.Bt = (const bf16_t*)(ws + (size_t)ll * WL + W_UP); g.K = 1024; g.zA = 0; g.zB = 0;
                        TileOrder S; S.init(Tg, NUP, gridDim.x, cwg, 1);
                        gemm_phase(lds, g, S, E);
                        if (!gc.sample && gridDim.x == 256) {
                            const int nl = (gi == 1) ? ll + 1 : ll, ng = (gi == 1) ? 0 : 1, lo = 128, hi = (gi == 0) ? 248 : 212;
                            if (nl < 2 && (int)blockIdx.x >= lo && (int)blockIdx.x < hi) { const size_t nbase = (size_t)ng * TGMAX * D;
                                phase_xb((nl == 0) ? p.x_prompt + nbase : p.out + O_YP + nbase, (bf16_t*)(ws + OFF_XB2), TGMAX, (int)blockIdx.x - lo, hi - lo); }
                        }
                    } break;
                    case 9: {
                        phase_ffnfix(p, ll, gc, (const float*)AX(gc, A_H), (bf16_t*)AX(gc, A_G));
                    } break;
                    case 10: {
                        EpiRes E; E.res = (const float*)AX(gc, A_X1); E.dst = yreg;
                        Gemm g; g.A = (const bf16_t*)AX(gc, A_G); g.Bt = (const bf16_t*)(ws + (size_t)ll * WL + W_DN); g.K = DFF; g.zA = 0; g.zB = 0;
                        TileOrder S; S.init(Tg, 1024, gridDim.x, cwg, 1);
                        gemm_phase(lds, g, S, E);
                    } break;
                    default: {
                        phase_ln(yreg, (gc.sample && ll + 1 < 2) ? (bf16_t*)AX(gc, A_XB) : nullptr, p.ln2_g + (size_t)ll * D, p.ln2_b + (size_t)ll * D, Tg);
                        if (gc.sample) { if (ll + 1 < 2) phase_cache(p, ll + 1); }
                        else if (gridDim.x != 256) {
                            const int nl = (gi == 1) ? ll + 1 : ll, ng = (gi == 1) ? 0 : 1;
                            if (nl < 2) { const size_t nbase = (size_t)ng * TGMAX * D; phase_xb((nl == 0) ? p.x_prompt + nbase : p.out + O_YP + nbase, (bf16_t*)(ws + OFF_XB2), TGMAX); }
                        }
                    } break;
                    }
                }
                NEXT();
            }
        }
    }
}

constexpr size_t kDynLds = 160 * 1024;
extern "C" void kernel_launch(void* const* d_in, const int* in_sizes, int n_in, void* d_out, int out_size, void* d_ws, size_t ws_size, hipStream_t stream) {
    Params p{};
    const float** f = (const float**)&p;
    for (int i = 0; i < 23; ++i) f[i] = (const float*)d_in[i];
    p.out = (float*)d_out; p.ws = (unsigned char*)d_ws; p.pad = 0;
    static int inited = 0, grid_blocks = 0;
    if (!inited) {
        hipFuncSetAttribute((const void*)mega, hipFuncAttributeMaxDynamicSharedMemorySize, (int)kDynLds);
        int dev = 0, cus = 0, per_cu = 0; hipGetDevice(&dev); hipDeviceGetAttribute(&cus, hipDeviceAttributeMultiprocessorCount, dev);
        hipOccupancyMaxActiveBlocksPerMultiprocessor(&per_cu, mega, 512, kDynLds);
        if (per_cu < 1) per_cu = 1; grid_blocks = cus * 1; inited = 1;
    }
#ifdef MULTI_LAUNCH
    for (int ph = 0; ph < DBG_NPH; ++ph) { p.lo = ph; p.hi = ph + 1; p.coop = 0; hipLaunchKernelGGL(mega, dim3(grid_blocks), dim3(512), kDynLds, stream, p); }
#else
    p.lo = 0; p.hi = NPH; p.coop = 1;
    (void)hipMemsetAsync((unsigned char*)d_ws + OFF_BAR, 0, XCD_BAR_WORDS * sizeof(unsigned), stream);
    void* args[] = {&p};
    hipError_t e = hipLaunchCooperativeKernel((const void*)mega, dim3(grid_blocks), dim3(512), args, kDynLds, stream);
    if (e != hipSuccess) fprintf(stderr, "cooperative launch failed: %s (grid %d)\n", hipGetErrorString(e), grid_blocks);
#endif
}
```

```cpp
#include <hip/hip_runtime.h>
#include <hip/hip_cooperative_groups.h>
#include <hip/hip_fp16.h>
#include <cstdio>
namespace cg = cooperative_groups;
#define DBG_NPH NPH
#define DBG_ATTN 1

#define LAS __attribute__((address_space(3)))
typedef unsigned short bf16_t;
typedef short bf16x8 __attribute__((ext_vector_type(8)));
typedef float f32x4 __attribute__((ext_vector_type(4)));
typedef unsigned u32x4 __attribute__((ext_vector_type(4)));
typedef unsigned u32x2 __attribute__((ext_vector_type(2)));

constexpr int D = 1024, SEQ = 8192, NB = 4, DB = 8, DS = 64, PAST = 2048, LCAT = PAST + DS;
constexpr int INC = 7748, NP1 = 7936, DFF = 2816, NUP = 5632;
constexpr float ALPHA = 1.41421356237309515f, LN_EPS = 1e-5f, IDX_SCALE = 0.0625f;
constexpr int TGMAX = 16384;
constexpr size_t MiB = 1u << 20;
constexpr size_t O_YP = 0, O_YS = O_YP + (size_t)NB * SEQ * D, O_KP = O_YS + (size_t)DB * DS * D, O_VP = O_KP + (size_t)2 * NB * SEQ * 128,
                 O_KIP = O_VP + (size_t)2 * NB * SEQ * 128, O_HP = O_KIP + (size_t)2 * NB * SEQ * 64, O_SCP = O_HP + (size_t)2 * NB * 4 * 16384,
                 O_FFP = O_SCP + (size_t)2 * NB * 2 * 512, O_KS = O_FFP + (size_t)2 * NB * 2 * NUP, O_VS = O_KS + (size_t)2 * DB * DS * 128,
                 O_KIS = O_VS + (size_t)2 * DB * DS * 128, O_HS = O_KIS + (size_t)2 * DB * DS * 64, O_SCS = O_HS + (size_t)2 * DB * 4 * 16384,
                 O_FFS = O_SCS + (size_t)2 * DB * 2 * 512;
constexpr size_t W_IN = 0, W_BR = W_IN + (size_t)NP1 * 1024 * 2, W_OUT = W_BR + (size_t)3 * 1024 * 512 * 2, W_UP = W_OUT + (size_t)1024 * 1024 * 2,
                 W_DN = W_UP + (size_t)NUP * 1024 * 2, W_END = W_DN + (size_t)1024 * DFF * 2;
constexpr size_t WL = 37 * MiB, OFF_ROT = 74 * MiB, OFF_BAR = 74 * MiB + 768 * 1024, AR = 75 * MiB;
constexpr size_t A_XB = AR, A_Q = AR + 32 * MiB, A_KB = AR + 48 * MiB, A_VB = AR + 52 * MiB + MiB / 2, A_QI = AR + 57 * MiB, A_KIB = AR + 65 * MiB,
                 A_IW = AR + 67 * MiB + MiB / 4, A_HQ = AR + 68 * MiB, A_LF = AR + 84 * MiB, A_KH = AR + 100 * MiB, A_HV = AR + 116 * MiB, A_HG = AR + 132 * MiB,
                 A_CB = AR + 148 * MiB, A_U = AR + 164 * MiB, A_GATES = AR + 180 * MiB, A_YA = AR + 276 * MiB, A_ST = AR + 324 * MiB, A_DEC = AR + 356 * MiB,
                 A_MPART = AR + 68 * MiB, A_MERGED = AR + 32 * MiB, A_X1 = AR + 88 * MiB, A_X1B = AR + 152 * MiB, A_H = AR + 184 * MiB, A_G = AR;
constexpr size_t OFF_XB2 = 460 * MiB;
static_assert(OFF_XB2 + 32 * MiB <= 512 * MiB, "xb2 overflow");
constexpr size_t SAR = 436 * MiB, S_KB = 448 * MiB, S_VB = 452 * MiB + MiB / 2, S_KIB = 457 * MiB;
static_assert(S_KIB + 3 * MiB <= 512 * MiB, "sample arena overflow");
static_assert(W_END <= WL, "weights overflow");
static_assert(A_H + (size_t)TGMAX * NUP * 2 <= 512 * MiB && A_DEC + MiB <= 512 * MiB, "arena overflow");

struct Params {
    const float *x_prompt, *x_sample, *cache_k, *cache_v, *cache_ik, *state_hgrn, *state_sconv, *state_ffn;
    const float *w_in, *lb_logits, *norm_g, *sconv_w, *sconv_b, *w_branch, *w_out, *ln1_g, *ln1_b, *w_up, *ffn_cw, *ffn_cb, *w_down, *ln2_g, *ln2_b;
    float* out; unsigned char* ws;
    int lo, hi, coop, pad;
};

typedef float f32x2_ __attribute__((ext_vector_type(2)));
typedef __bf16 bf16x2_ __attribute__((ext_vector_type(2)));
__device__ __forceinline__ unsigned cvt_pk_bf16(float lo, float hi) { const f32x2_ v = {lo, hi}; const bf16x2_ b = __builtin_convertvector(v, bf16x2_); return __builtin_bit_cast(unsigned, b); }
__device__ __forceinline__ float bflo(unsigned w) { return __uint_as_float(w << 16); }
__device__ __forceinline__ float bfhi(unsigned w) { return __uint_as_float(w & 0xffff0000u); }
__device__ __forceinline__ float bf2f(bf16_t b) { return __uint_as_float(((unsigned)b) << 16); }
__device__ __forceinline__ bf16_t f2bf(float f) { return (bf16_t)(cvt_pk_bf16(f, 0.f) & 0xffffu); }
__device__ __forceinline__ u32x4 pack8(const f32x4 a, const f32x4 b) { u32x4 w; w.x = cvt_pk_bf16(a[0], a[1]); w.y = cvt_pk_bf16(a[2], a[3]); w.z = cvt_pk_bf16(b[0], b[1]); w.w = cvt_pk_bf16(b[2], b[3]); return w; }
__device__ __forceinline__ void unpack8(const u32x4 w, float* f) { f[0] = bflo(w.x); f[1] = bfhi(w.x); f[2] = bflo(w.y); f[3] = bfhi(w.y); f[4] = bflo(w.z); f[5] = bfhi(w.z); f[6] = bflo(w.w); f[7] = bfhi(w.w); }
__device__ __forceinline__ float fsigmoid(float x) { return __builtin_amdgcn_rcpf(1.0f + __expf(-x)); }
__device__ __forceinline__ float fsilu(float x) { return x * fsigmoid(x); }
__device__ __forceinline__ int mbcnt64(unsigned long long m) { return __builtin_amdgcn_mbcnt_hi((unsigned)(m >> 32), __builtin_amdgcn_mbcnt_lo((unsigned)m, 0u)); }
__device__ __forceinline__ int tid_opaque() { int t = threadIdx.x; asm volatile("" : "+v"(t)); return t; }
template <class T> __device__ __forceinline__ T* sgpr_opaque(T* p) {
    unsigned lo = (unsigned)(unsigned long long)p, hi = (unsigned)((unsigned long long)p >> 32);
    lo = __builtin_amdgcn_readfirstlane(lo); hi = __builtin_amdgcn_readfirstlane(hi);
    asm volatile("" : "+s"(lo), "+s"(hi));
    return (T*)(((unsigned long long)hi << 32) | (unsigned long long)lo);
}
#define MFMA16(a, b, c) __builtin_amdgcn_mfma_f32_16x16x32_bf16((a), (b), (c), 0, 0, 0)

constexpr int BM = 256, BK = 64, HALF = 128, HTB = HALF * BK * 2, NXCD = 8, WGM = 8;
__device__ __forceinline__ int lds_byte(int r, int c) { const int st = (r >> 4) * 2 + (c >> 5), rr = r & 15, cc = c & 31, ob = rr * 64 + cc * 2; return st * 1024 + (ob ^ (((ob >> 9) & 1) << 5)); }
__device__ __forceinline__ void stage_rc(int b, int& R, int& C) { const int st = b / 1024, sb = b % 1024, swz = sb ^ (((sb >> 9) & 1) << 5); R = (st >> 1) * 16 + swz / 64; C = (st & 1) * 32 + (swz % 64) / 2; }
__device__ __forceinline__ int perm32(int rho) { const int n = rho >> 4, i = rho & 15; return 8 * (i >> 2) + 4 * n + (i & 3); }
struct Unit { int pm, pn, z; };
struct Gemm { const bf16_t* A; const bf16_t* Bt; int K; size_t zA, zB; };
struct TileOrder {
    int nM, nN, nwg, G, c, NZ;
    __device__ void init(int M, int N, int G_, int c_, int nz) { nM = M / BM; nN = N / BM; nwg = nM * nN; G = G_; c = c_; NZ = nz; }
    __device__ bool next(int i, Unit& u) const {
        const int it = i / NZ; u.z = i - it * NZ;
        const long L = (long)it * G + c; if (L >= nwg) return false;
        int wgid = (int)L; { const int q = nwg / NXCD, r = nwg % NXCD, xcd = wgid % NXCD, off = wgid / NXCD; wgid = (xcd < r ? xcd * (q + 1) : r * (q + 1) + (xcd - r) * q) + off; }
        const int nig = WGM * nN, gid = wgid / nig, fm = gid * WGM, gsz = (nM - fm) < WGM ? (nM - fm) : WGM;
        u.pm = fm + ((wgid % nig) % gsz); u.pn = (wgid % nig) / gsz; return true;
    }
};
template <class Epi>
__device__ __forceinline__ void gemm_phase(LAS unsigned char* lds, const Gemm g, const TileOrder& S, const Epi& E) {
    const int tid = tid_opaque(), wid = __builtin_amdgcn_readfirstlane(tid >> 6), lane = tid & 63, wr = wid >> 2, wc = wid & 3, fr = lane & 15, fq = lane >> 4;
    const int K = g.K, nt = K / BK;
    unsigned voffA[2], voffB[2];
#pragma unroll
    for (int i = 0; i < 2; ++i) { int R, C; stage_rc(tid * 16 + i * 8192, R, C); const int Rb = (R & ~31) + perm32(R & 31);
        voffA[i] = (unsigned)(R * K + C) * 2u; voffB[i] = (unsigned)(Rb * K + C) * 2u; }
    const size_t kstep = (size_t)(BK * 2), hstep = (size_t)HALF * K * 2, tstep = 2 * hstep;
    const unsigned ldsw = (unsigned)wid * 1024u;
    const int aoff = lds_byte(wr * 64 + fr, fq * 8), boff = lds_byte(wc * 32 + fr, fq * 8);
#define PG_SA(b, h) (((b) * 2 + (h)) * HTB)
#define PG_SB(b, h) ((4 + (b) * 2 + (h)) * HTB)
#define PG_STAGE(bufoff, gbase, voff) do { _Pragma("unroll") for (int _i = 0; _i < 2; ++_i) \
        __builtin_amdgcn_global_load_lds((const unsigned*)((const char*)(gbase) + (voff)[_i]), (LAS unsigned*)(lds + (bufoff) + ldsw + _i * 8192), 16, 0, 0); } while (0)
#define PG_LDA(dst, b, h) do { _Pragma("unroll") for (int m = 0; m < 4; ++m) _Pragma("unroll") for (int k = 0; k < 2; ++k) dst[m][k] = *(const LAS bf16x8*)(lds + PG_SA(b, h) + aoff + m * 2048 + k * 1024); } while (0)
#define PG_LDB(dst, b, h) do { _Pragma("unroll") for (int n = 0; n < 2; ++n) _Pragma("unroll") for (int k = 0; k < 2; ++k) dst[n][k] = *(const LAS bf16x8*)(lds + PG_SB(b, h) + boff + n * 2048 + k * 1024); } while (0)
#define PG_MMA(ai, bj, At, Bt) do { __builtin_amdgcn_s_setprio(1); _Pragma("unroll") for (int m = 0; m < 4; ++m) _Pragma("unroll") for (int n = 0; n < 2; ++n) _Pragma("unroll") for (int k = 0; k < 2; ++k) \
        acc[ai][bj][m][n] = __builtin_amdgcn_mfma_f32_16x16x32_bf16(Bt[n][k], At[m][k], acc[ai][bj][m][n], 0, 0, 0); __builtin_amdgcn_s_setprio(0); } while (0)
#define PG_WAIT_V(n) asm volatile("s_waitcnt vmcnt(" #n ")" ::: "memory")
#define PG_WAIT_L(n) asm volatile("s_waitcnt lgkmcnt(" #n ")" ::: "memory")
#define PG_BAR __builtin_amdgcn_s_barrier()
#define PG_SCHED __builtin_amdgcn_sched_barrier(0)
    Unit cur, nxt; int ui = 0;
    if (!S.next(0, cur)) return;
    f32x4 acc[2][2][4][2];
#pragma unroll
    for (int a = 0; a < 2; ++a)
#pragma unroll
        for (int b = 0; b < 2; ++b)
#pragma unroll
            for (int m = 0; m < 4; ++m)
#pragma unroll
                for (int n = 0; n < 2; ++n) acc[a][b][m][n] = (f32x4){0.f, 0.f, 0.f, 0.f};
    bf16x8 At[4][2], B0[2][2], B1[2][2];
    const char* cA = (const char*)g.A + ((size_t)cur.z * g.zA) * 2 + (size_t)cur.pm * tstep; const char* cB = (const char*)g.Bt + ((size_t)cur.z * g.zB) * 2 + (size_t)cur.pn * tstep;
    PG_STAGE(PG_SB(0, 0), cB, voffB); PG_STAGE(PG_SA(0, 0), cA, voffA); PG_STAGE(PG_SB(0, 1), cB + hstep, voffB); PG_STAGE(PG_SA(0, 1), cA + hstep, voffA);
    if (wr == 1) PG_BAR;
    PG_WAIT_V(4); PG_BAR;
    PG_STAGE(PG_SB(1, 0), cB + kstep, voffB); PG_STAGE(PG_SA(1, 0), cA + kstep, voffA); PG_STAGE(PG_SB(1, 1), cB + hstep + kstep, voffB);
    PG_WAIT_V(6); PG_BAR;
    for (;;) {
        const bool has_next = S.next(ui + 1, nxt);
        const char* nA = has_next ? (const char*)g.A + ((size_t)nxt.z * g.zA) * 2 + (size_t)nxt.pm * tstep : cA;
        const char* nB = has_next ? (const char*)g.Bt + ((size_t)nxt.z * g.zB) * 2 + (size_t)nxt.pn * tstep : cB;
        for (int t = 0; t < nt; t += 2) {
            const bool last = (t == nt - 2);
            const char* a1 = cA + (size_t)(t + 1) * kstep;
            const char* a2 = last ? nA : cA + (size_t)(t + 2) * kstep; const char* b2 = last ? nB : cB + (size_t)(t + 2) * kstep;
            const char* a3 = a2 + kstep; const char* b3 = b2 + kstep;
            if constexpr (Epi::HOOK) { if (t == 8 || t == 16) E.mid(acc, cur, wr, wc, fr, fq, t >> 3); }
            PG_LDB(B0, 0, 0); PG_SCHED; PG_LDA(At, 0, 0); PG_STAGE(PG_SA(1, 1), a1 + hstep, voffA);
            PG_WAIT_L(8); PG_BAR; PG_WAIT_L(0); PG_MMA(0, 0, At, B0); PG_BAR; PG_SCHED;
            PG_LDB(B1, 0, 1); PG_STAGE(PG_SB(0, 0), b2, voffB);
            PG_BAR; PG_WAIT_L(0); PG_MMA(0, 1, At, B1); PG_BAR;
            PG_LDA(At, 0, 1); PG_STAGE(PG_SA(0, 0), a2, voffA);
            PG_BAR; PG_WAIT_L(0); PG_MMA(1, 0, At, B0); PG_BAR; PG_SCHED;
            PG_STAGE(PG_SB(0, 1), b2 + hstep, voffB);
            PG_WAIT_V(6); PG_BAR; PG_MMA(1, 1, At, B1); PG_BAR;
            PG_LDB(B0, 1, 0); PG_SCHED; PG_LDA(At, 1, 0); PG_STAGE(PG_SA(0, 1), a2 + hstep, voffA);
            PG_WAIT_L(8); PG_BAR; PG_WAIT_L(0); PG_MMA(0, 0, At, B0); PG_BAR; PG_SCHED;
            PG_LDB(B1, 1, 1); PG_STAGE(PG_SB(1, 0), b3, voffB);
            PG_BAR; PG_WAIT_L(0); PG_MMA(0, 1, At, B1); PG_BAR;
            PG_LDA(At, 1, 1); PG_STAGE(PG_SA(1, 0), a3, voffA);
            PG_BAR; PG_WAIT_L(0); PG_MMA(1, 0, At, B0); PG_BAR; PG_SCHED;
            PG_STAGE(PG_SB(1, 1), b3 + hstep, voffB);
            PG_WAIT_V(6); PG_BAR; PG_MMA(1, 1, At, B1); PG_BAR;
        }
        E(acc, cur, wr, wc, fr, fq);
        if (!has_next) break;
#pragma unroll
        for (int a = 0; a < 2; ++a)
#pragma unroll
            for (int b = 0; b < 2; ++b)
#pragma unroll
                for (int m = 0; m < 4; ++m)
#pragma unroll
                    for (int n = 0; n < 2; ++n) acc[a][b][m][n] = (f32x4){0.f, 0.f, 0.f, 0.f};
        cur = nxt; cA = nA; cB = nB; ++ui;
    }
    PG_WAIT_V(0);
    if (wr == 0) PG_BAR;
    PG_BAR;
}

struct GroupCtx {
    int sample, Tg, gbaseT, nbat, Lk;
    unsigned char *ab, *kb, *vb, *kib; int sh, rev;
};
#define AX(gc_, A_) ((gc_).ab + ((size_t)((A_) - AR) >> (gc_).sh))
__device__ __forceinline__ void rotary8(f32x4& v0, f32x4& v1, const float2* rr, bool act, int fq) {
    f32x4 p0, p1;
#pragma unroll
    for (int j = 0; j < 4; ++j) { p0[j] = __shfl_xor(v0[j], 16); p1[j] = __shfl_xor(v1[j], 16); }
    if (act) {
#pragma unroll
        for (int j = 0; j < 4; ++j) { const float2 c0 = rr[j], c1 = rr[4 + j]; const float s0 = fq ? c0.y : -c0.y, s1 = fq ? c1.y : -c1.y;
            v0[j] = v0[j] * c0.x + p0[j] * s0; v1[j] = v1[j] * c1.x + p1[j] * s1; }
    }
}
struct Epi1 {
    static constexpr bool HOOK = false;
    unsigned char* ws; float* out; const float* lbl;
    int layer; GroupCtx gc;
    __device__ __forceinline__ void operator()(const f32x4 (&acc)[2][2][4][2], const Unit& un, int wr, int wc, int fr_, int fq_) const {
        int fr = fr_, fq = fq_; asm volatile("" : "+v"(fr), "+v"(fq));
        const int pn = un.pn; unsigned char* const ws = sgpr_opaque(this->ws);
        bf16_t* const q = (bf16_t*)AX(gc, A_Q); bf16_t* const kbuf = (bf16_t*)gc.kb; bf16_t* const vbuf = (bf16_t*)gc.vb; bf16_t* const qi = (bf16_t*)AX(gc, A_QI); bf16_t* const kibuf = (bf16_t*)gc.kib;
        bf16_t* const hq = (bf16_t*)AX(gc, A_HQ); bf16_t* const lf = (bf16_t*)AX(gc, A_LF); bf16_t* const kh = (bf16_t*)AX(gc, A_KH); bf16_t* const hv = (bf16_t*)AX(gc, A_HV); bf16_t* const hg = (bf16_t*)AX(gc, A_HG);
        bf16_t* const cb = (bf16_t*)AX(gc, A_CB); bf16_t* const u = (bf16_t*)AX(gc, A_U); bf16_t* const gates = (bf16_t*)AX(gc, A_GATES); float* const iw = (float*)AX(gc, A_IW);
        const float2* const rot = (const float2*)(ws + OFF_ROT);
        const size_t l_ = (size_t)layer;
        float* const outk = gc.sample ? out + O_KS + l_ * DB * DS * 128 : out + O_KP + (l_ * NB * SEQ + gc.gbaseT) * 128;
        float* const outv = gc.sample ? out + O_VS + l_ * DB * DS * 128 : out + O_VP + (l_ * NB * SEQ + gc.gbaseT) * 128;
        float* const outki = gc.sample ? out + O_KIS + l_ * DB * DS * 64 : out + O_KIP + (l_ * NB * SEQ + gc.gbaseT) * 64;
        float* const outsc = gc.sample ? out + O_SCS + l_ * DB * 2 * 512 : out + O_SCP + l_ * NB * 2 * 512;
#pragma unroll
        for (int ai = 0; ai < 2; ++ai)
#pragma unroll
            for (int m = 0; m < 4; ++m) {
                const int row = un.pm * BM + ai * HALF + wr * 64 + m * 16 + fr;
                int pos, krow, bidx;
                if (gc.sample) { pos = PAST + (row & 63); bidx = row >> 6; krow = bidx * LCAT + pos; } else { pos = (gc.gbaseT + row) & (SEQ - 1); bidx = (gc.gbaseT + row) >> 13; krow = row; }
                const float2* rr = rot + (size_t)pos * 8;
                const bool ract = ((wc & 1) == 0) && (fq < 2);
#pragma unroll
                for (int bj = 0; bj < 2; ++bj) {
                    f32x4 v0 = acc[ai][bj][m][0], v1 = acc[ai][bj][m][1];
                    const int c8 = bj * HALF + wc * 32 + fq * 8;
                    if (pn < 2) {
                        if ((wc & 1) == 0) rotary8(v0, v1, rr, ract, fq);
                        *(u32x4*)(q + (size_t)row * 512 + pn * 256 + c8) = pack8(v0 * 0.125f, v1 * 0.125f);
                    } else if (pn == 2) {
                        if (bj == 0) { if ((wc & 1) == 0) rotary8(v0, v1, rr, ract, fq);
                            float* o = outk + (size_t)row * 128 + (c8 & 127); *(f32x4*)o = v0; *(f32x4*)(o + 4) = v1;
                            *(u32x4*)(kbuf + (size_t)krow * 128 + (c8 & 127)) = pack8(v0, v1);
                        } else { float* o = outv + (size_t)row * 128 + (c8 & 127); *(f32x4*)o = v0; *(f32x4*)(o + 4) = v1;
                            *(u32x4*)(vbuf + (size_t)krow * 128 + (c8 & 127)) = pack8(v0, v1); }
                    } else if (pn == 3) {
                        if ((wc & 1) == 0) rotary8(v0, v1, rr, ract, fq);
                        *(u32x4*)(qi + (size_t)row * 256 + c8) = pack8(v0, v1);
                    } else if (pn == 4) {
                        if (bj == 0) {
                            if (wc == 0) rotary8(v0, v1, rr, ract, fq);
                            if (wc < 2) { float* o = outki + (size_t)row * 64 + c8; *(f32x4*)o = v0; *(f32x4*)(o + 4) = v1;
                                *(u32x4*)(kibuf + (size_t)krow * 64 + c8) = pack8(v0, v1); }
                            else if (wc == 2 && fq == 0) *(f32x4*)(iw + (size_t)row * 4) = v0 * IDX_SCALE;
                        }
                    } else if (pn < 7) {
#pragma unroll
                        for (int j = 0; j < 4; ++j) { v0[j] = fsilu(v0[j]); v1[j] = fsilu(v1[j]); }
                        *(u32x4*)(hq + (size_t)row * 512 + (pn - 5) * 256 + c8) = pack8(v0, v1);
                    } else if (pn < 9) {
                        const int c = (pn - 7) * 256 + c8; f32x4 l0, l1, k0, k1;
#pragma unroll
                        for (int j = 0; j < 4; ++j) {
                            float lb0 = 0.f, lb1 = 0.f;
                            if (layer == 1) { lb0 = fsigmoid(lbl[512 + c + j] - lbl[c + j]); lb1 = fsigmoid(lbl[512 + c + 4 + j] - lbl[c + 4 + j]); }
                            const float f0 = lb0 + (1.f - lb0) * fsigmoid(v0[j]), f1 = lb1 + (1.f - lb1) * fsigmoid(v1[j]);
                            l0[j] = __logf(f0); l1[j] = __logf(f1); k0[j] = 1.f - f0; k1[j] = 1.f - f1; }
                        *(u32x4*)(lf + (size_t)row * 512 + c) = pack8(l0, l1); *(u32x4*)(kh + (size_t)row * 512 + c) = pack8(k0, k1);
                    } else if (pn < 11) {
                        *(u32x4*)(hv + (size_t)row * 512 + (pn - 9) * 256 + c8) = pack8(v0, v1);
                    } else if (pn < 13) {
#pragma unroll
                        for (int j = 0; j < 4; ++j) { v0[j] = fsilu(v0[j]); v1[j] = fsilu(v1[j]); }
                        *(u32x4*)(hg + (size_t)row * 512 + (pn - 11) * 256 + c8) = pack8(v0, v1);
                    } else if (pn < 15) {
                        *(u32x4*)(cb + (size_t)row * 512 + (pn - 13) * 256 + c8) = pack8(v0, v1);
                    } else if (pn < 19) {
                        if (bj == 1) { const f32x4 a0 = acc[ai][0][m][0] * v0, a1 = acc[ai][0][m][1] * v1; const int c = (pn - 15) * 128 + wc * 32 + fq * 8;
                            *(u32x4*)(u + (size_t)row * 512 + c) = pack8(a0, a1);
                            const int lastp = gc.sample ? (PAST + DS - 2) : (SEQ - 2);
                            if (pos >= lastp) { float* o = outsc + (size_t)(bidx * 2 + (pos - lastp)) * 512 + c; *(f32x4*)o = a0; *(f32x4*)(o + 4) = a1; } }
                    } else {
#pragma unroll
                        for (int j = 0; j < 4; ++j) { v0[j] = fsigmoid(v0[j]); v1[j] = fsigmoid(v1[j]); }
                        *(u32x4*)(gates + (size_t)row * 3072 + (pn - 19) * 256 + c8) = pack8(v0, v1);
                    }
                }
            }
    }
};
struct EpiMerge {
    static constexpr bool HOOK = true;
    const bf16_t* gates; bf16_t* merged;
    __device__ __forceinline__ void mid(f32x4 (&acc)[2][2][4][2], const Unit& un, int wr, int wc, int fr_, int fq_, int b) const {
        int fr = fr_, fq = fq_; asm volatile("" : "+v"(fr), "+v"(fq));
#pragma unroll
        for (int ai = 0; ai < 2; ++ai)
#pragma unroll
            for (int m = 0; m < 4; ++m) {
                const int row = un.pm * BM + ai * HALF + wr * 64 + m * 16 + fr;
#pragma unroll
                for (int bj = 0; bj < 2; ++bj) {
                    const int c = un.pn * BM + bj * HALF + wc * 32 + fq * 8;
                    const bf16_t* gp = gates + (size_t)row * 3072 + (b - 1) * 1024 + c;
                    float g0[8], g1[8]; unpack8(*(const u32x4*)gp, g0); unpack8(*(const u32x4*)(gp + 1024), g1);
#pragma unroll
                    for (int j = 0; j < 4; ++j) {
                        acc[ai][bj][m][0][j] *= fmaxf(g0[j], 1e-30f) * __builtin_amdgcn_rcpf(fmaxf(g1[j], 1e-30f));
                        acc[ai][bj][m][1][j] *= fmaxf(g0[4 + j], 1e-30f) * __builtin_amdgcn_rcpf(fmaxf(g1[4 + j], 1e-30f)); }
                }
            }
    }
    __device__ __forceinline__ void operator()(const f32x4 (&acc)[2][2][4][2], const Unit& un, int wr, int wc, int fr_, int fq_) const {
        int fr = fr_, fq = fq_; asm volatile("" : "+v"(fr), "+v"(fq));
#pragma unroll
        for (int ai = 0; ai < 2; ++ai)
#pragma unroll
            for (int m = 0; m < 4; ++m) {
                const int row = un.pm * BM + ai * HALF + wr * 64 + m * 16 + fr;
#pragma unroll
                for (int bj = 0; bj < 2; ++bj) {
                    const int c = un.pn * BM + bj * HALF + wc * 32 + fq * 8;
                    float gf[8]; unpack8(*(const u32x4*)(gates + (size_t)row * 3072 + 2048 + c), gf);
                    f32x4 v0 = acc[ai][bj][m][0], v1 = acc[ai][bj][m][1];
#pragma unroll
                    for (int j = 0; j < 4; ++j) { v0[j] *= fmaxf(gf[j], 1e-30f); v1[j] *= fmaxf(gf[4 + j], 1e-30f); }
                    *(u32x4*)(merged + (size_t)row * 1024 + c) = pack8(v0, v1);
                }
            }
    }
};
struct EpiRes {
    static constexpr bool HOOK = false;
    const float* res; float* dst;
    __device__ __forceinline__ void operator()(const f32x4 (&acc)[2][2][4][2], const Unit& un, int wr, int wc, int fr_, int fq_) const {
        int fr = fr_, fq = fq_; asm volatile("" : "+v"(fr), "+v"(fq));
#pragma unroll
        for (int ai = 0; ai < 2; ++ai)
#pragma unroll
            for (int m = 0; m < 4; ++m) {
                const int row = un.pm * BM + ai * HALF + wr * 64 + m * 16 + fr;
#pragma unroll
                for (int bj = 0; bj < 2; ++bj) {
                    const size_t o = (size_t)row * 1024 + un.pn * BM + bj * HALF + wc * 32 + fq * 8;
                    const f32x4 r0 = *(const f32x4*)(res + o), r1 = *(const f32x4*)(res + o + 4);
                    *(f32x4*)(dst + o) = r0 * ALPHA + acc[ai][bj][m][0]; *(f32x4*)(dst + o + 4) = r1 * ALPHA + acc[ai][bj][m][1];
                }
            }
    }
};
struct EpiUp {
    static constexpr bool HOOK = false;
    bf16_t* h; float* outff; GroupCtx gc;
    __device__ __forceinline__ void operator()(const f32x4 (&acc)[2][2][4][2], const Unit& un, int wr, int wc, int fr_, int fq_) const {
        int fr = fr_, fq = fq_; asm volatile("" : "+v"(fr), "+v"(fq));
#pragma unroll
        for (int ai = 0; ai < 2; ++ai)
#pragma unroll
            for (int m = 0; m < 4; ++m) {
                const int row = un.pm * BM + ai * HALF + wr * 64 + m * 16 + fr;
                int sp, bidx, S_;
                if (gc.sample) { sp = row & 63; bidx = row >> 6; S_ = DS; } else { sp = (gc.gbaseT + row) & (SEQ - 1); bidx = (gc.gbaseT + row) >> 13; S_ = SEQ; }
#pragma unroll
                for (int bj = 0; bj < 2; ++bj) {
                    const int c = un.pn * BM + bj * HALF + wc * 32 + fq * 8;
                    *(u32x4*)(h + (size_t)row * NUP + c) = pack8(acc[ai][bj][m][0], acc[ai][bj][m][1]);
                    if (sp >= S_ - 2) { float* o = outff + (size_t)(bidx * 2 + (sp - (S_ - 2))) * NUP + c; *(f32x4*)o = acc[ai][bj][m][0]; *(f32x4*)(o + 4) = acc[ai][bj][m][1]; }
                }
            }
    }
};

__device__ __forceinline__ float dpp_ror1(float x) { return __int_as_float(__builtin_amdgcn_update_dpp(0, __float_as_int(x), 0x121, 0xf, 0xf, false)); }
__device__ __forceinline__ float dpp_ror2(float x) { return __int_as_float(__builtin_amdgcn_update_dpp(0, __float_as_int(x), 0x122, 0xf, 0xf, false)); }
struct EpiUpConv {
    static constexpr bool HOOK = false;
    bf16_t* gout; float* halo; float* outff; const float* cw; const float* cbias; GroupCtx gc;
    __device__ __forceinline__ void operator()(const f32x4 (&acc)[2][2][4][2], const Unit& un, int wr, int wc, int fr_, int fq_) const {
        int fr = fr_, fq = fq_; asm volatile("" : "+v"(fr), "+v"(fq));
#pragma unroll
        for (int n = 0; n < 2; ++n) {
            const int ca = un.pn * 128 + wc * 32 + fq * 8 + 4 * n;
            const f32x4 wa0 = *(const f32x4*)(cw + ca), wa1 = *(const f32x4*)(cw + NUP + ca), wa2 = *(const f32x4*)(cw + 2 * NUP + ca), ba = *(const f32x4*)(cbias + ca);
            const f32x4 wb0 = *(const f32x4*)(cw + DFF + ca), wb1 = *(const f32x4*)(cw + NUP + DFF + ca), wb2 = *(const f32x4*)(cw + 2 * NUP + DFF + ca), bb = *(const f32x4*)(cbias + DFF + ca);
#pragma unroll
            for (int ai = 0; ai < 2; ++ai)
#pragma unroll
                for (int m = 0; m < 4; ++m) {
                    const int row = un.pm * BM + ai * HALF + wr * 64 + m * 16 + fr;
                    const f32x4 ha = acc[ai][0][m][n], hb = acc[ai][1][m][n];
                    const f32x4 pa = acc[ai][0][m > 0 ? m - 1 : 0][n], pb = acc[ai][1][m > 0 ? m - 1 : 0][n];
                    f32x4 oa, ob;
#pragma unroll
                    for (int j = 0; j < 4; ++j) {
                        const float a1 = dpp_ror1((m > 0 && fr == 15) ? pa[j] : ha[j]), a2 = dpp_ror2((m > 0 && fr >= 14) ? pa[j] : ha[j]);
                        const float b1 = dpp_ror1((m > 0 && fr == 15) ? pb[j] : hb[j]), b2 = dpp_ror2((m > 0 && fr >= 14) ? pb[j] : hb[j]);
                        oa[j] = ba[j] + wa0[j] * a2 + wa1[j] * a1 + wa2[j] * ha[j];
                        ob[j] = bb[j] + wb0[j] * b2 + wb1[j] * b1 + wb2[j] * hb[j];
                    }
                    if (!(m == 0 && fr < 2)) {
                        u32x2 wv; wv.x = cvt_pk_bf16(fsilu(oa[0]) * ob[0], fsilu(oa[1]) * ob[1]); wv.y = cvt_pk_bf16(fsilu(oa[2]) * ob[2], fsilu(oa[3]) * ob[3]);
                        *(u32x2*)(gout + (size_t)row * DFF + ca) = wv;
                    }
                    int slot = -1;
                    if (m == 3 && fr >= 14) slot = fr - 14; else if (m == 0 && fr < 2) slot = 2 + fr;
                    if (slot >= 0) { float* hp = halo + ((size_t)(row >> 6) * 4 + slot) * NUP + ca; *(f32x4*)hp = ha; *(f32x4*)(hp + DFF) = hb; }
                    if (m == 3 && fr >= 14) {
                        int sp, bidx, S_;
                        if (gc.sample) { sp = row & 63; bidx = row >> 6; S_ = DS; } else { sp = (gc.gbaseT + row) & (SEQ - 1); bidx = (gc.gbaseT + row) >> 13; S_ = SEQ; }
                        if (sp >= S_ - 2) { float* o = outff + (size_t)(bidx * 2 + (sp - (S_ - 2))) * NUP + ca; *(f32x4*)o = ha; *(f32x4*)(o + DFF) = hb; }
                    }
                }
        }
    }
};
__device__ __forceinline__ void phase_ffnfix(const Params& p, int l, const GroupCtx& gc, const float* __restrict__ halo, bf16_t* __restrict__ gout) {
    const float* cw = p.ffn_cw + (size_t)l * 3 * NUP; const float* cbias = p.ffn_cb + (size_t)l * NUP;
    const float* hist = p.state_ffn + (size_t)l * DB * 2 * NUP;
    constexpr int NC4 = DFF / 4; const int total = (gc.Tg / 64) * 2 * NC4;
    for (int e = blockIdx.x * 512 + tid_opaque(); e < total; e += gridDim.x * 512) {
        const int c = (e % NC4) * 4, rq = e / NC4, q = rq & 1, blk = rq >> 1, row = blk * 64 + q;
        int sp0, bidx; if (gc.sample) { sp0 = (blk * 64) & 63; bidx = blk; } else { sp0 = (gc.gbaseT + blk * 64) & (SEQ - 1); bidx = 0; }
        f32x4 o[2];
#pragma unroll
        for (int hf = 0; hf < 2; ++hf) {
            const int cc = c + hf * DFF;
            const float* hb = halo + (size_t)blk * 4 * NUP + cc;
            const f32x4 cur = *(const f32x4*)(hb + (size_t)(2 + q) * NUP);
            f32x4 p1, p2;
            if (sp0 > 0) { const float* hpv = halo + (size_t)(blk - 1) * 4 * NUP + cc;
                if (q == 0) { p1 = *(const f32x4*)(hpv + NUP); p2 = *(const f32x4*)hpv; } else { p1 = *(const f32x4*)(hb + 2 * NUP); p2 = *(const f32x4*)(hpv + NUP); } }
            else if (gc.sample) { const float* hs = hist + (size_t)bidx * 2 * NUP + cc;
                if (q == 0) { p1 = *(const f32x4*)(hs + NUP); p2 = *(const f32x4*)hs; } else { p1 = *(const f32x4*)(hb + 2 * NUP); p2 = *(const f32x4*)(hs + NUP); } }
            else { const f32x4 z = (f32x4){0.f, 0.f, 0.f, 0.f}; if (q == 0) { p1 = z; p2 = z; } else { p1 = *(const f32x4*)(hb + 2 * NUP); p2 = z; } }
            o[hf] = *(const f32x4*)(cbias + cc) + *(const f32x4*)(cw + cc) * p2 + *(const f32x4*)(cw + NUP + cc) * p1 + *(const f32x4*)(cw + 2 * NUP + cc) * cur;
        }
        u32x2 wv; wv.x = cvt_pk_bf16(fsilu(o[0][0]) * o[1][0], fsilu(o[0][1]) * o[1][1]); wv.y = cvt_pk_bf16(fsilu(o[0][2]) * o[1][2], fsilu(o[0][3]) * o[1][3]);
        *(u32x2*)(gout + (size_t)row * DFF + c) = wv;
    }
}

__device__ __forceinline__ int win_src_col(int n) {
    if (n < 1092) return n;
    if (n < 1280) return -1;
    if (n < 3840) return n - 188;
    if (n < 4864) { const int r = n - 3840, t = r >> 8, s = (r >> 7) & 1, i = r & 127; return (s ? 4164 : 3652) + 128 * t + i; }
    return n - 188;
}
__device__ __forceinline__ int up_src_col(int n) { return ((n >> 7) & 1) * DFF + (n >> 8) * 128 + (n & 127); }
template <int MAP> __device__ __forceinline__ void convT(const float* W, int ldw, bf16_t* Bt, int K, int Npad, LAS float* tile) {
    const int tid = tid_opaque(), ntn = Npad / 64, ntk = K / 64, ntile = ntn * ntk;
    LAS float* tileB = tile + 64 * 65;
    for (int t = blockIdx.x; t < ntile; t += 2 * gridDim.x) {
        const int t1 = t + gridDim.x; const bool has1 = t1 < ntile;
        const int tn0 = t % ntn, tk0 = t / ntn, tn1 = has1 ? t1 % ntn : tn0, tk1 = has1 ? t1 / ntn : tk0;
        { const int j = tid & 63, i0 = tid >> 6; const int n0 = tn0 * 64 + j, n1 = tn1 * 64 + j; const int s0 = MAP == 1 ? win_src_col(n0) : (MAP == 2 ? up_src_col(n0) : n0), s1 = MAP == 1 ? win_src_col(n1) : (MAP == 2 ? up_src_col(n1) : n1);
            float a[8], b[8];
#pragma unroll
            for (int q = 0; q < 8; ++q) { const int i = i0 + 8 * q; a[q] = s0 >= 0 ? W[(size_t)(tk0 * 64 + i) * ldw + s0] : 0.f; b[q] = (has1 && s1 >= 0) ? W[(size_t)(tk1 * 64 + i) * ldw + s1] : 0.f; }
#pragma unroll
            for (int q = 0; q < 8; ++q) { const int i = i0 + 8 * q; tile[j * 65 + i] = a[q]; tileB[j * 65 + i] = b[q]; } }
        __syncthreads();
        { const int nl = tid >> 3, kc = (tid & 7) * 8;
            { LAS const float* tp = tile + nl * 65 + kc; u32x4 w; w.x = cvt_pk_bf16(tp[0], tp[1]); w.y = cvt_pk_bf16(tp[2], tp[3]); w.z = cvt_pk_bf16(tp[4], tp[5]); w.w = cvt_pk_bf16(tp[6], tp[7]);
              *(u32x4*)(Bt + (size_t)(tn0 * 64 + nl) * K + tk0 * 64 + kc) = w; }
            if (has1) { LAS const float* tp = tileB + nl * 65 + kc; u32x4 w; w.x = cvt_pk_bf16(tp[0], tp[1]); w.y = cvt_pk_bf16(tp[2], tp[3]); w.z = cvt_pk_bf16(tp[4], tp[5]); w.w = cvt_pk_bf16(tp[6], tp[7]);
              *(u32x4*)(Bt + (size_t)(tn1 * 64 + nl) * K + tk1 * 64 + kc) = w; } }
        __syncthreads();
    }
}
__device__ __forceinline__ void phase_weights(const Params& p, int l, LAS unsigned char* lds) {
    LAS float* tile = (LAS float*)lds; unsigned char* ws = p.ws + (size_t)l * WL;
    convT<1>(p.w_in + (size_t)l * 1024 * INC, INC, (bf16_t*)(ws + W_IN), 1024, NP1, tile);
    convT<0>(p.w_branch + (size_t)l * 3 * 512 * 1024, 1024, (bf16_t*)(ws + W_BR), 1536, 1024, tile);
    convT<0>(p.w_out + (size_t)l * 1024 * 1024, 1024, (bf16_t*)(ws + W_OUT), 1024, 1024, tile);
    convT<2>(p.w_up + (size_t)l * 1024 * NUP, NUP, (bf16_t*)(ws + W_UP), 1024, NUP, tile);
    convT<0>(p.w_down + (size_t)l * DFF * 1024, 1024, (bf16_t*)(ws + W_DN), DFF, 1024, tile);
    if (l == 0) {
        const float invf[8] = {1.0f, 0.1939227432012558f, 0.03760603070259094f, 0.007292664609849453f, 0.0014142135623842478f, 0.00027424818836152554f, 5.318296098266728e-05f, 1.0313386155758053e-05f};
        float2* rot = (float2*)(p.ws + OFF_ROT);
        for (int e = blockIdx.x * 512 + tid_opaque(); e < SEQ * 8; e += gridDim.x * 512) {
            const int i = e & 7, pos = e >> 3; float fi = invf[0];
#pragma unroll
            for (int k = 1; k < 8; ++k) fi = (i == k) ? invf[k] : fi;
            const float ang = (float)pos * fi; const double a = (double)ang;
            const double kk = rint(a * 0.15915494309189535); const double r = fma(-kk, 6.283185307179586, a);
            const double r2 = r * r; double s = 1.0, c = 1.0;
#pragma unroll
            for (int k = 14; k >= 1; --k) { s = 1.0 - s * r2 / (double)((2 * k) * (2 * k + 1)); c = 1.0 - c * r2 / (double)((2 * k - 1) * (2 * k)); }
            rot[e] = make_float2((float)c, (float)(s * r));
        }
    }
}
__device__ __forceinline__ void phase_xb(const float* x, bf16_t* xb, int Tg, int wgi = -1, int nwg = 0) {
    const size_t n8 = (size_t)Tg * 1024 / 8;
    if (wgi < 0) { wgi = blockIdx.x; nwg = gridDim.x; }
    for (size_t i = (size_t)wgi * 512 + tid_opaque(); i < n8; i += (size_t)nwg * 512) {
        const f32x4 a = *(const f32x4*)(x + i * 8), b = *(const f32x4*)(x + i * 8 + 4); *(u32x4*)(xb + i * 8) = pack8(a, b); }
}
__device__ __forceinline__ void phase_cache(const Params& p, int l) {
    bf16_t* kb = (bf16_t*)(p.ws + S_KB); bf16_t* vb = (bf16_t*)(p.ws + S_VB); bf16_t* kib = (bf16_t*)(p.ws + S_KIB);
    const int n1 = DB * PAST * 16, n2 = DB * PAST * 8;
    for (int i = blockIdx.x * 512 + tid_opaque(); i < 2 * n1 + n2; i += gridDim.x * 512) {
        const float* src; bf16_t* dst; int e, w;
        if (i < n1) { e = i; w = 16; src = p.cache_k + (size_t)l * DB * PAST * 128; dst = kb; } else if (i < 2 * n1) { e = i - n1; w = 16; src = p.cache_v + (size_t)l * DB * PAST * 128; dst = vb; }
        else { e = i - 2 * n1; w = 8; src = p.cache_ik + (size_t)l * DB * PAST * 64; dst = kib; }
        const int rowi = e / w, cg8 = e % w, b = rowi / PAST, j = rowi % PAST;
        const float* s = src + ((size_t)rowi * w + cg8) * 8; const f32x4 a = *(const f32x4*)s, c = *(const f32x4*)(s + 4);
        *(u32x4*)(dst + ((size_t)(b * LCAT + j) * w + cg8) * 8) = pack8(a, c);
    }
}

__device__ __forceinline__ void phase_ln(float* x, bf16_t* xb, const float* g, const float* b, int Tg) {
    constexpr int NR = 4;
    const int tid_ = tid_opaque(); const int lane = tid_ & 63, w = tid_ >> 6;
    const int stride = gridDim.x * 8;
    f32x4 gg[4], bb[4];
#pragma unroll
    for (int i = 0; i < 4; ++i) { gg[i] = *(const f32x4*)(g + i * 256 + lane * 4); bb[i] = *(const f32x4*)(b + i * 256 + lane * 4); }
    for (int row0 = blockIdx.x * 8 + w; row0 < Tg; row0 += NR * stride) {
        f32x4 v[NR][4];
#pragma unroll
        for (int rr = 0; rr < NR; ++rr) { const int row = row0 + rr * stride;
#pragma unroll
            for (int i = 0; i < 4; ++i) v[rr][i] = (row < Tg) ? *(const f32x4*)(x + (size_t)row * 1024 + i * 256 + lane * 4) : (f32x4){0.f, 0.f, 0.f, 0.f}; }
#pragma unroll
        for (int rr = 0; rr < NR; ++rr) {
            const int row = row0 + rr * stride;
            if (row < Tg) {
                float* xr = x + (size_t)row * 1024; float s = 0.f;
#pragma unroll
                for (int i = 0; i < 4; ++i) s += (v[rr][i][0] + v[rr][i][1]) + (v[rr][i][2] + v[rr][i][3]);
#pragma unroll
                for (int o = 32; o >= 1; o >>= 1) s += __shfl_xor(s, o);
                const float mu = s * (1.f / 1024.f); float q = 0.f;
#pragma unroll
                for (int i = 0; i < 4; ++i) { v[rr][i] -= mu; q += (v[rr][i][0] * v[rr][i][0] + v[rr][i][1] * v[rr][i][1]) + (v[rr][i][2] * v[rr][i][2] + v[rr][i][3] * v[rr][i][3]); }
#pragma unroll
                for (int o = 32; o >= 1; o >>= 1) q += __shfl_xor(q, o);
                const float rstd = rsqrtf(q * (1.f / 1024.f) + LN_EPS);
#pragma unroll
                for (int i = 0; i < 4; ++i) { const int c = i * 256 + lane * 4;
                    const f32x4 y = v[rr][i] * rstd * gg[i] + bb[i]; *(f32x4*)(xr + c) = y;
                    if (xb) { u32x2 w2; w2.x = cvt_pk_bf16(y[0], y[1]); w2.y = cvt_pk_bf16(y[2], y[3]); *(u32x2*)(xb + (size_t)row * 1024 + c) = w2; } }
            }
        }
    }
}

__device__ __forceinline__ void phase_ffnconv(const Params& p, int l, const GroupCtx& gc, const bf16_t* __restrict__ h, bf16_t* __restrict__ gout) {
    const float* cw = p.ffn_cw + (size_t)l * 3 * NUP; const float* cbias = p.ffn_cb + (size_t)l * NUP;
    const float* hist = p.state_ffn + (size_t)l * DB * 2 * NUP;
    constexpr int NCG = DFF / 8, RB = 32; const int total = (gc.Tg / RB) * NCG;
    for (int e = blockIdx.x * 512 + tid_opaque(); e < total; e += gridDim.x * 512) {
        const int cg8 = (e % NCG) * 8, row0 = (e / NCG) * RB;
        int sp0, bidx; if (gc.sample) { sp0 = row0 & 63; bidx = row0 >> 6; } else { sp0 = (gc.gbaseT + row0) & (SEQ - 1); bidx = 0; }
        float w0[2][8], w1[2][8], w2[2][8], bs[2][8], p2[2][8], p1[2][8];
#pragma unroll
        for (int hf = 0; hf < 2; ++hf) {
            const int cc = cg8 + hf * DFF;
#pragma unroll
            for (int j = 0; j < 8; ++j) { w0[hf][j] = cw[cc + j]; w1[hf][j] = cw[NUP + cc + j]; w2[hf][j] = cw[2 * NUP + cc + j]; bs[hf][j] = cbias[cc + j]; }
            if (sp0 >= 2) { unpack8(*(const u32x4*)(h + (size_t)(row0 - 2) * NUP + cc), p2[hf]); unpack8(*(const u32x4*)(h + (size_t)(row0 - 1) * NUP + cc), p1[hf]); }
            else if (gc.sample) {
#pragma unroll
                for (int j = 0; j < 8; ++j) { p2[hf][j] = hist[(size_t)(bidx * 2 + 0) * NUP + cc + j]; p1[hf][j] = hist[(size_t)(bidx * 2 + 1) * NUP + cc + j]; } }
            else {
#pragma unroll
                for (int j = 0; j < 8; ++j) { p2[hf][j] = 0.f; p1[hf][j] = 0.f; } }
        }
#pragma unroll 4
        for (int r = 0; r < RB; ++r) {
            const bf16_t* hp = h + (size_t)(row0 + r) * NUP + cg8;
            float ca[8], cb2[8]; unpack8(*(const u32x4*)hp, ca); unpack8(*(const u32x4*)(hp + DFF), cb2);
            float oa[8], ob[8];
#pragma unroll
            for (int j = 0; j < 8; ++j) {
                oa[j] = bs[0][j] + w0[0][j] * p2[0][j] + w1[0][j] * p1[0][j] + w2[0][j] * ca[j];
                ob[j] = bs[1][j] + w0[1][j] * p2[1][j] + w1[1][j] * p1[1][j] + w2[1][j] * cb2[j];
                p2[0][j] = p1[0][j]; p1[0][j] = ca[j]; p2[1][j] = p1[1][j]; p1[1][j] = cb2[j];
            }
            u32x4 wv;
            wv.x = cvt_pk_bf16(fsilu(oa[0]) * ob[0], fsilu(oa[1]) * ob[1]); wv.y = cvt_pk_bf16(fsilu(oa[2]) * ob[2], fsilu(oa[3]) * ob[3]);
            wv.z = cvt_pk_bf16(fsilu(oa[4]) * ob[4], fsilu(oa[5]) * ob[5]); wv.w = cvt_pk_bf16(fsilu(oa[6]) * ob[6], fsilu(oa[7]) * ob[7]);
            *(u32x4*)(gout + (size_t)(row0 + r) * DFF + cg8) = wv;
        }
    }
}

__device__ __forceinline__ void phase_sconv(const Params& p, int l, const GroupCtx& gc, const bf16_t* cb, const bf16_t* u, bf16_t* yc) {
    const float* cw = p.sconv_w + (size_t)l * 3 * 512; const float* cbias = p.sconv_b + (size_t)l * 512;
    const float* hist = p.state_sconv + (size_t)l * DB * 2 * 512;
    const size_t total = (size_t)gc.Tg * 64;
    for (size_t e = (size_t)blockIdx.x * 512 + tid_opaque(); e < total; e += (size_t)gridDim.x * 512) {
        const int row = (int)(e >> 6), c = (int)(e & 63) * 8;
        int sp, bidx; if (gc.sample) { sp = row & 63; bidx = row >> 6; } else { sp = (gc.gbaseT + row) & (SEQ - 1); bidx = 0; }
        float a[8];
#pragma unroll
        for (int j = 0; j < 8; ++j) a[j] = cbias[c + j];
#pragma unroll
        for (int k = 0; k < 3; ++k) {
            const int sr = sp - 2 + k; float hv[8];
            if (sr >= 0) { unpack8(*(const u32x4*)(u + (size_t)(row - 2 + k) * 512 + c), hv); }
            else if (gc.sample) { const float* hp = hist + (size_t)(bidx * 2 + (sr + 2)) * 512 + c;
#pragma unroll
                for (int j = 0; j < 8; ++j) hv[j] = hp[j]; }
            else {
#pragma unroll
                for (int j = 0; j < 8; ++j) hv[j] = 0.f; }
#pragma unroll
            for (int j = 0; j < 8; ++j) a[j] += cw[k * 512 + c + j] * hv[j];
        }
        float cv[8]; unpack8(*(const u32x4*)(cb + (size_t)row * 512 + c), cv);
        u32x4 w; w.x = cvt_pk_bf16(cv[0] * a[0], cv[1] * a[1]); w.y = cvt_pk_bf16(cv[2] * a[2], cv[3] * a[3]); w.z = cvt_pk_bf16(cv[4] * a[4], cv[5] * a[5]); w.w = cvt_pk_bf16(cv[6] * a[6], cv[7] * a[7]);
        *(u32x4*)(yc + (size_t)row * 1536 + c) = w;
    }
}

typedef unsigned short u16x2 __attribute__((ext_vector_type(2)));
__device__ __forceinline__ int sc_pos(int j) { return (((j >> 7) * 64 + (j & 63)) << 1) | ((j >> 6) & 1); }
__device__ __forceinline__ int wave_sum(int v) {
    v += __builtin_amdgcn_update_dpp(0, v, 0x128, 0xf, 0xf, false);
    v += __builtin_amdgcn_update_dpp(0, v, 0x124, 0xf, 0xf, false);
    v += __builtin_amdgcn_update_dpp(0, v, 0x122, 0xf, 0xf, false);
    v += __builtin_amdgcn_update_dpp(0, v, 0x121, 0xf, 0xf, false);
    return (__builtin_amdgcn_readlane(v, 0) + __builtin_amdgcn_readlane(v, 16)) + (__builtin_amdgcn_readlane(v, 32) + __builtin_amdgcn_readlane(v, 48));
}
template <int J, unsigned M> __device__ __forceinline__ void tstage32(unsigned (&A)[32]) {
#pragma unroll
    for (int k = 0; k < 32; ++k) if ((k & J) == 0) { const unsigned a = A[k], b = A[k + J]; A[k] = (a & M) | ((b << J) & ~M); A[k + J] = ((a >> J) & M) | (b & ~M); }
}
__device__ __forceinline__ void transpose32(unsigned (&A)[32]) {
    tstage32<16, 0x0000FFFFu>(A); tstage32<8, 0x00FF00FFu>(A); tstage32<4, 0x0F0F0F0Fu>(A); tstage32<2, 0x33333333u>(A); tstage32<1, 0x55555555u>(A);
}
template <int R2>
__device__ __forceinline__ int select_topk(LAS const unsigned* rowp, LAS unsigned short* list, int ntarget, int nk, int lane) {
    constexpr int NBLK = (R2 + 31) / 32;
    unsigned W[NBLK][32];
#pragma unroll
    for (int blk = 0; blk < NBLK; ++blk) {
#pragma unroll
        for (int c = 0; c < 32; ++c) { const int r = blk * 32 + c; W[blk][c] = (r < R2) ? rowp[r * 64 + lane] : 0u; }
        transpose32(W[blk]);
#pragma unroll
        for (int h = 0; h < 2; ++h) { const unsigned sg = W[blk][16 * h + 15];
#pragma unroll
            for (int b = 0; b < 15; ++b) W[blk][16 * h + b] ^= sg;
            W[blk][16 * h + 15] = ~sg; }
    }
    const int nr = nk >> 6;
    unsigned alive[NBLK][2], sel[NBLK][2];
#pragma unroll
    for (int blk = 0; blk < NBLK; ++blk)
#pragma unroll
        for (int h = 0; h < 2; ++h) { const int t = nr - blk * 64 - h + 1; int nj = t <= 0 ? 0 : (t >> 1); nj = nj > 32 ? 32 : nj;
            alive[blk][h] = nj >= 32 ? 0xffffffffu : ((1u << nj) - 1u); sel[blk][h] = 0u; }
    int need = ntarget; bool done = false;
#pragma unroll
    for (int b = 15; b >= 0; --b) if (!done) {
        unsigned ones[NBLK][2]; int c = 0;
#pragma unroll
        for (int blk = 0; blk < NBLK; ++blk)
#pragma unroll
            for (int h = 0; h < 2; ++h) { ones[blk][h] = alive[blk][h] & W[blk][16 * h + b]; c += __popc(ones[blk][h]); }
        c = wave_sum(c);
        if (c >= need) {
#pragma unroll
            for (int blk = 0; blk < NBLK; ++blk)
#pragma unroll
                for (int h = 0; h < 2; ++h) alive[blk][h] = ones[blk][h];
            if (c == need) {
#pragma unroll
                for (int blk = 0; blk < NBLK; ++blk)
#pragma unroll
                    for (int h = 0; h < 2; ++h) { sel[blk][h] |= alive[blk][h]; alive[blk][h] = 0u; }
                need = 0; done = true;
            }
        } else {
            need -= c;
#pragma unroll
            for (int blk = 0; blk < NBLK; ++blk)
#pragma unroll
                for (int h = 0; h < 2; ++h) { sel[blk][h] |= ones[blk][h]; alive[blk][h] ^= ones[blk][h]; }
        }
    }
    if (need > 0) {
        int ca = 0;
#pragma unroll
        for (int blk = 0; blk < NBLK; ++blk)
#pragma unroll
            for (int h = 0; h < 2; ++h) ca += __popc(alive[blk][h]);
        ca = wave_sum(ca);
        if (ca == need) {
#pragma unroll
            for (int blk = 0; blk < NBLK; ++blk)
#pragma unroll
                for (int h = 0; h < 2; ++h) sel[blk][h] |= alive[blk][h];
        } else {
#pragma unroll
            for (int blk = 0; blk < NBLK; ++blk)
                for (int j = 0; j < 32; ++j)
#pragma unroll
                    for (int h = 0; h < 2; ++h) {
                        const bool bit = ((alive[blk][h] >> j) & 1u) != 0u; const unsigned long long m = __ballot(bit);
                        if (bit && mbcnt64(m) < need) sel[blk][h] |= 1u << j;
                        const int cnt = __popcll(m); need -= cnt < need ? cnt : need;
                    }
        }
    }
    int n = 0;
#pragma unroll
    for (int blk = 0; blk < NBLK; ++blk)
#pragma unroll
        for (int h = 0; h < 2; ++h) n += __popc(sel[blk][h]);
    int incl = n;
#pragma unroll
    for (int o = 1; o < 64; o <<= 1) { const int t = __shfl_up(incl, o); if (lane >= o) incl += t; }
    int pos = incl - n;
#pragma unroll
    for (int blk = 0; blk < NBLK; ++blk)
#pragma unroll
        for (int h = 0; h < 2; ++h) { unsigned m = sel[blk][h];
            while (m) { const int j = __builtin_ctz(m); m &= m - 1u; list[pos] = (unsigned short)((blk * 64 + 2 * j + h) * 64 + lane); ++pos; } }
    return ntarget;
}
struct AttnArgs { unsigned char* ws; GroupCtx gc; };
__device__ __forceinline__ void attn_item(const AttnArgs& a, int item, LAS unsigned char* lds) {
    const int tid = tid_opaque(), w = tid >> 6, lane = tid & 63, g = lane >> 4, c16 = lane & 15;
    const bf16_t* const aq = (const bf16_t*)AX(a.gc, A_Q); const bf16_t* const aqi = (const bf16_t*)AX(a.gc, A_QI); const bf16_t* const akb = (const bf16_t*)a.gc.kb; const bf16_t* const avb = (const bf16_t*)a.gc.vb;
    const bf16_t* const akib = (const bf16_t*)a.gc.kib; const float* const aiw = (const float*)AX(a.gc, A_IW); bf16_t* const aya = (bf16_t*)AX(a.gc, A_YA);
    int qrow0, krow0, nk;
    if (a.gc.sample) { qrow0 = item * 8; krow0 = (qrow0 >> 6) * LCAT; nk = LCAT; }
    else { const int c = 127 - (item >> 4), bl = (item >> 3) & 1, sub = item & 7; qrow0 = bl * SEQ + c * 64 + sub * 8; krow0 = bl * SEQ; nk = 64 * (c + 1); }
    const int R = nk <= 2048 ? 32 : (nk <= 4096 ? 64 : 128);
    LAS unsigned short* sc = (LAS unsigned short*)lds;
    LAS unsigned short* listall = (LAS unsigned short*)(lds + 131072);
    LAS float* invs = (LAS float*)(lds + 131072 + 4096);
    __syncthreads();
    {
        bf16x8 qa[2][2]; f32x4 iwv[2];
#pragma unroll
        for (int mb = 0; mb < 2; ++mb) {
            const int qr = qrow0 + 4 * mb + (c16 >> 2), h = c16 & 3;
#pragma unroll
            for (int kh = 0; kh < 2; ++kh) qa[mb][kh] = *(const bf16x8*)(aqi + (size_t)qr * 256 + h * 64 + kh * 32 + g * 8);
            iwv[mb] = *(const f32x4*)(aiw + (size_t)(qrow0 + 4 * mb + g) * 4);
        }
        const int ntile = nk >> 4;
        for (int kt0 = w; kt0 < ntile; kt0 += 64) {
            bf16x8 b0[8], b1[8];
#pragma unroll
            for (int i = 0; i < 8; ++i) { const int kt = kt0 + 8 * i; if (kt < ntile) { const bf16_t* kp = akib + (size_t)(krow0 + kt * 16 + c16) * 64 + g * 8; b0[i] = *(const bf16x8*)kp; b1[i] = *(const bf16x8*)(kp + 32); } }
#pragma unroll
            for (int i = 0; i < 8; ++i) { const int kt = kt0 + 8 * i; if (kt < ntile) { const int key = kt * 16 + c16;
#pragma unroll
                for (int mb = 0; mb < 2; ++mb) {
                    f32x4 d = (f32x4){0.f, 0.f, 0.f, 0.f}; d = MFMA16(qa[mb][0], b0[i], d); d = MFMA16(qa[mb][1], b1[i], d);
                    float s = 0.f;
#pragma unroll
                    for (int j = 0; j < 4; ++j) s += iwv[mb][j] * fmaxf(d[j], 0.f);
                    const unsigned hb = (unsigned)__half_as_ushort(__float2half_rn(s));
                    sc[(4 * mb + g) * 8192 + sc_pos(key)] = (unsigned short)hb;
                } } }
        }
    }
    __syncthreads();
    LAS unsigned short* list = listall + w * 256;
    const int ntarget = nk < 256 ? nk : 256;
    int nsel;
    { LAS const unsigned* rp = (LAS const unsigned*)(sc + w * 8192);
      if (R == 32) nsel = select_topk<16>(rp, list, ntarget, nk, lane); else if (R == 64) nsel = select_topk<32>(rp, list, ntarget, nk, lane); else nsel = select_topk<64>(rp, list, ntarget, nk, lane); }
    asm volatile("s_waitcnt lgkmcnt(0)" ::: "memory");
    const int qr = qrow0 + w;
    LAS float* pbuf = (LAS float*)(sc + w * 8192);
    const int ksub = lane >> 4, kvh = c16 >> 3;
    const bf16_t* vbase = avb + (size_t)krow0 * 128 + c16 * 8;
    u32x4 vA[8];
    {
        bf16x8 qb[4];
#pragma unroll
        for (int ks = 0; ks < 4; ++ks) {
            const bool valid = (c16 < 8) && ((c16 >> 2) == (ks >> 1));
            bf16x8 z = {0, 0, 0, 0, 0, 0, 0, 0};
            qb[ks] = valid ? *(const bf16x8*)(aq + (size_t)qr * 512 + c16 * 64 + (ks & 1) * 32 + g * 8) : z;
        }
        const int ntile = nsel >> 4;
        f32x4 lg[16];
#pragma unroll
        for (int t = 0; t < 16; ++t) {
            lg[t] = (f32x4){-1e30f, -1e30f, -1e30f, -1e30f};
            if (t < ntile) {
                const int idx = list[t * 16 + c16]; const bf16_t* kp = akb + (size_t)(krow0 + idx) * 128 + g * 8;
                f32x4 d = (f32x4){0.f, 0.f, 0.f, 0.f};
#pragma unroll
                for (int ks = 0; ks < 4; ++ks) d = MFMA16(*(const bf16x8*)(kp + ks * 32), qb[ks], d);
                lg[t] = d;
            }
        }
#pragma unroll
        for (int i = 0; i < 8; ++i) { const int idx = list[4 * i + ksub]; vA[i] = *(const u32x4*)(vbase + (size_t)idx * 128); }
        float mx = -1e30f;
#pragma unroll
        for (int t = 0; t < 16; ++t) mx = fmaxf(mx, fmaxf(fmaxf(lg[t][0], lg[t][1]), fmaxf(lg[t][2], lg[t][3])));
        mx = fmaxf(mx, __shfl_xor(mx, 16)); mx = fmaxf(mx, __shfl_xor(mx, 32));
        float sum = 0.f;
#pragma unroll
        for (int t = 0; t < 16; ++t) {
            if (t < ntile) {
#pragma unroll
                for (int j = 0; j < 4; ++j) { const float pv = __expf(lg[t][j] - mx); sum += pv; if (c16 < 8) pbuf[(t * 16 + 4 * g + j) * 8 + c16] = pv; }
            }
        }
        sum += __shfl_xor(sum, 16); sum += __shfl_xor(sum, 32);
        if (c16 < 8 && g == 0) invs[w * 8 + c16] = 1.0f / sum;
    }
    asm volatile("s_waitcnt lgkmcnt(0)" ::: "memory");
    {
        typedef float f32x2 __attribute__((ext_vector_type(2)));
        f32x2 o2[4][4];
#pragma unroll
        for (int hh = 0; hh < 4; ++hh)
#pragma unroll
            for (int d = 0; d < 4; ++d) o2[hh][d] = (f32x2){0.f, 0.f};
        auto pv_acc = [&](const u32x4 (&vv)[8], int nb) {
#pragma unroll
            for (int i = 0; i < 8; ++i) {
                const f32x4 p4 = *(const LAS f32x4*)(pbuf + (nb + 4 * i + ksub) * 8 + kvh * 4);
                f32x2 v2[4]; v2[0] = (f32x2){bflo(vv[i].x), bfhi(vv[i].x)}; v2[1] = (f32x2){bflo(vv[i].y), bfhi(vv[i].y)}; v2[2] = (f32x2){bflo(vv[i].z), bfhi(vv[i].z)}; v2[3] = (f32x2){bflo(vv[i].w), bfhi(vv[i].w)};
#pragma unroll
                for (int hh = 0; hh < 4; ++hh) { const f32x2 pp = (f32x2){p4[hh], p4[hh]};
#pragma unroll
                    for (int d = 0; d < 4; ++d) o2[hh][d] = __builtin_elementwise_fma(pp, v2[d], o2[hh][d]); }
            }
        };
        for (int n0 = 0; n0 < nsel; n0 += 64) {
            u32x4 vB[8];
#pragma unroll
            for (int i = 0; i < 8; ++i) { const int idx = list[n0 + 32 + 4 * i + ksub]; vB[i] = *(const u32x4*)(vbase + (size_t)idx * 128); }
            pv_acc(vA, n0);
            if (n0 + 64 < nsel) {
#pragma unroll
                for (int i = 0; i < 8; ++i) { const int idx = list[n0 + 64 + 4 * i + ksub]; vA[i] = *(const u32x4*)(vbase + (size_t)idx * 128); }
            }
            pv_acc(vB, n0 + 32);
        }
        float o[4][8];
#pragma unroll
        for (int hh = 0; hh < 4; ++hh)
#pragma unroll
            for (int d = 0; d < 4; ++d) { float a0 = o2[hh][d].x, a1 = o2[hh][d].y;
                a0 += __shfl_xor(a0, 16); a0 += __shfl_xor(a0, 32); a1 += __shfl_xor(a1, 16); a1 += __shfl_xor(a1, 32); o[hh][2 * d] = a0; o[hh][2 * d + 1] = a1; }
        if (ksub == 0) {
#pragma unroll
            for (int hh = 0; hh < 4; ++hh) { const int h = kvh * 4 + hh; const float inv = invs[w * 8 + h];
                u32x4 wv; wv.x = cvt_pk_bf16(o[hh][0] * inv, o[hh][1] * inv); wv.y = cvt_pk_bf16(o[hh][2] * inv, o[hh][3] * inv); wv.z = cvt_pk_bf16(o[hh][4] * inv, o[hh][5] * inv); wv.w = cvt_pk_bf16(o[hh][6] * inv, o[hh][7] * inv);
                *(u32x4*)(aya + (size_t)qr * 1536 + h * 64 + (c16 & 7) * 8) = wv; }
        }
    }
}

struct HgrnArgs { unsigned char* ws; const float* ng; GroupCtx gc; };
#define HG_PTRS const bf16_t* const hq_ = (const bf16_t*)AX(a.gc, A_HQ); const bf16_t* const lf_ = (const bf16_t*)AX(a.gc, A_LF); const bf16_t* const kh_ = (const bf16_t*)AX(a.gc, A_KH); const bf16_t* const hv_ = (const bf16_t*)AX(a.gc, A_HV); \
    const bf16_t* const hg_ = (const bf16_t*)AX(a.gc, A_HG); bf16_t* const st_p = (bf16_t*)AX(a.gc, A_ST); float* const dec_ = (float*)AX(a.gc, A_DEC); bf16_t* const yb_ = (bf16_t*)AX(a.gc, A_YA) + 512;
__device__ __forceinline__ void hgrn_item(const GroupCtx& gc, int item, int& bh, int& ch, int& r0, int& hb) {
    if (gc.sample) { bh = item; ch = 0; r0 = (item >> 2) * 64; hb = (item & 3) * 128; }
    else { bh = item >> 7; ch = item & 127; r0 = (bh >> 2) * SEQ + ch * 64; hb = (bh & 3) * 128; }
}
__device__ __forceinline__ void hgrn_cum(const bf16_t* lf, int r0, int hb, int p, int dk, LAS float* tot, float (&c)[16], float& last, float& mid) {
    float s = 0.f;
#pragma unroll
    for (int i = 0; i < 16; ++i) { s += bf2f(lf[(size_t)(r0 + p * 16 + i) * 512 + hb + dk]); c[i] = s; }
    tot[p * 128 + dk] = s;
    __syncthreads();
    const float t0 = tot[dk], t1 = tot[128 + dk], t2 = tot[256 + dk], t3 = tot[384 + dk];
    const float off = (p > 0 ? t0 : 0.f) + (p > 1 ? t1 : 0.f) + (p > 2 ? t2 : 0.f);
#pragma unroll
    for (int i = 0; i < 16; ++i) c[i] += off;
    last = (t0 + t1) + (t2 + t3); mid = t0 + t1;
}
constexpr int LDQ = 136, LDS_ = 72;
__device__ __forceinline__ void hgrn_pass1(const HgrnArgs& a, int item, LAS unsigned char* lds) {
    const int tid = tid_opaque(), w = tid >> 6, lane = tid & 63, g = lane >> 4, c16 = lane & 15, p = tid >> 7, dk = tid & 127;
    int bh, ch, r0, hb; hgrn_item(a.gc, item, bh, ch, r0, hb); HG_PTRS
    LAS bf16_t* KT = (LAS bf16_t*)lds;
    LAS bf16_t* VT = (LAS bf16_t*)(lds + 128 * LDS_ * 2);
    LAS float* tot = (LAS float*)(lds + 2 * 128 * LDS_ * 2);
    __syncthreads();
    unsigned short kraw[16], vraw[16];
#pragma unroll
    for (int i = 0; i < 16; ++i) { const size_t o0 = (size_t)(r0 + p * 16 + i) * 512 + hb + dk; kraw[i] = kh_[o0]; vraw[i] = hv_[o0]; }
    float c[16], last, mid; hgrn_cum(lf_, r0, hb, p, dk, tot, c, last, mid);
    {
        unsigned kw[8], vw[8];
#pragma unroll
        for (int i = 0; i < 16; i += 2) {
            const float k0 = bf2f(kraw[i]) * __expf(last - c[i]), k1 = bf2f(kraw[i + 1]) * __expf(last - c[i + 1]);
            kw[i >> 1] = cvt_pk_bf16(k0, k1); vw[i >> 1] = (unsigned)vraw[i] | ((unsigned)vraw[i + 1] << 16);
        }
        LAS u32x4* kd = (LAS u32x4*)(KT + dk * LDS_ + p * 16); kd[0] = (u32x4){kw[0], kw[1], kw[2], kw[3]}; kd[1] = (u32x4){kw[4], kw[5], kw[6], kw[7]};
        LAS u32x4* vd = (LAS u32x4*)(VT + dk * LDS_ + p * 16); vd[0] = (u32x4){vw[0], vw[1], vw[2], vw[3]}; vd[1] = (u32x4){vw[4], vw[5], vw[6], vw[7]};
        if (p == 3) dec_[(size_t)(bh * (a.gc.sample ? 1 : 128) + ch) * 128 + dk] = __expf(last);
    }
    __syncthreads();
    {
        bf16x8 ka[2];
#pragma unroll
        for (int ks = 0; ks < 2; ++ks) ka[ks] = *(const LAS bf16x8*)(KT + (w * 16 + c16) * LDS_ + ks * 32 + g * 8);
        bf16_t* stp = st_p + (size_t)(bh * (a.gc.sample ? 1 : 128) + ch) * 16384;
#pragma unroll
        for (int dvt = 0; dvt < 8; ++dvt) {
            f32x4 d = (f32x4){0.f, 0.f, 0.f, 0.f};
#pragma unroll
            for (int ks = 0; ks < 2; ++ks) d = MFMA16(ka[ks], *(const LAS bf16x8*)(VT + (dvt * 16 + c16) * LDS_ + ks * 32 + g * 8), d);
            u32x2 wv; wv.x = cvt_pk_bf16(d[0], d[1]); wv.y = cvt_pk_bf16(d[2], d[3]);
            *(u32x2*)(stp + (size_t)(dvt * 16 + c16) * 128 + w * 16 + 4 * g) = wv;
        }
    }
}
__device__ __forceinline__ void hgrn_scan(const Params& p, int l, const GroupCtx& gc, bf16_t* __restrict__ st, const float* __restrict__ dec, int gidx, int only_bh) {
    const int nbh = gc.nbat * 4, nch = gc.sample ? 1 : 128; const int nwi = nbh * 64;
    float* outp = p.out + (gc.sample ? O_HS + (size_t)l * DB * 4 * 16384 : O_HP + ((size_t)l * NB + gidx * 2) * 4 * 16384);
    const int tid = tid_opaque(), w = tid >> 6, lane = tid & 63;
    const int wi0 = only_bh >= 0 ? only_bh * 64 + w : (int)blockIdx.x + w * (int)gridDim.x, wi1 = only_bh >= 0 ? only_bh * 64 + 64 : nwi, wis = only_bh >= 0 ? 8 : (int)gridDim.x * 8;
    for (int wi = wi0; wi < wi1; wi += wis) {
        const int bh = wi >> 6, dv = (wi & 63) * 2 + (lane >> 5), dk0 = (lane & 31) * 4;
        float S[4];
#pragma unroll
        for (int j = 0; j < 4; ++j) S[j] = gc.sample ? p.state_hgrn[((size_t)l * DB * 4 + bh) * 16384 + (size_t)(dk0 + j) * 128 + dv] : 0.f;
        bf16_t* sp = st + (size_t)bh * nch * 16384 + dv * 128 + dk0;
        const float* dp = dec + (size_t)bh * nch * 128 + dk0;
        for (int c0 = 0; c0 < nch; c0 += 16) {
            u32x2 U[16]; f32x4 Dv[16];
#pragma unroll
            for (int i = 0; i < 16; ++i) if (c0 + i < nch) { U[i] = *(const u32x2*)(sp + (size_t)(c0 + i) * 16384); Dv[i] = *(const f32x4*)(dp + (size_t)(c0 + i) * 128); }
#pragma unroll
            for (int i = 0; i < 16; ++i) if (c0 + i < nch) {
                u32x2 wv; wv.x = cvt_pk_bf16(S[0], S[1]); wv.y = cvt_pk_bf16(S[2], S[3]);
                *(u32x2*)(sp + (size_t)(c0 + i) * 16384) = wv;
                S[0] = Dv[i][0] * S[0] + bflo(U[i].x); S[1] = Dv[i][1] * S[1] + bfhi(U[i].x); S[2] = Dv[i][2] * S[2] + bflo(U[i].y); S[3] = Dv[i][3] * S[3] + bfhi(U[i].y);
            }
        }
#pragma unroll
        for (int j = 0; j < 4; ++j) outp[(size_t)bh * 16384 + (size_t)(dk0 + j) * 128 + dv] = S[j];
    }
}
__device__ __forceinline__ void hgrn_pass3(const HgrnArgs& a, int item, LAS unsigned char* lds) {
    const int tid = tid_opaque(), w = tid >> 6, lane = tid & 63, g = lane >> 4, c16 = lane & 15, p = tid >> 7, dk = tid & 127;
    int bh, ch, r0, hb; hgrn_item(a.gc, item, bh, ch, r0, hb); HG_PTRS
    LAS bf16_t* QT = (LAS bf16_t*)lds;
    LAS bf16_t* QP = QT + 64 * LDQ;
    LAS bf16_t* KT = QP + 64 * LDQ;
    LAS bf16_t* VT = KT + 64 * LDQ;
    LAS bf16_t* PM = VT + 128 * LDS_;
    LAS float* tot = (LAS float*)(PM + 64 * LDS_);
    LAS float* red = tot + 512;
    __syncthreads();
    unsigned short qraw[16], kraw[16], vraw[16];
#pragma unroll
    for (int i = 0; i < 16; ++i) { const size_t o0 = (size_t)(r0 + p * 16 + i) * 512 + hb + dk; qraw[i] = hq_[o0]; kraw[i] = kh_[o0]; vraw[i] = hv_[o0]; }
    bf16x8 sa[4]; u32x2 gwv[4];
    {   const bf16_t* stp0 = st_p + (size_t)(bh * (a.gc.sample ? 1 : 128) + ch) * 16384 + (size_t)(w * 16 + c16) * 128 + g * 8;
#pragma unroll
        for (int ks = 0; ks < 4; ++ks) sa[ks] = *(const bf16x8*)(stp0 + ks * 32);
#pragma unroll
        for (int tt = 0; tt < 4; ++tt) gwv[tt] = *(const u32x2*)(hg_ + (size_t)(r0 + tt * 16 + c16) * 512 + hb + w * 16 + 4 * g); }
    const f32x4 gn = *(const f32x4*)(a.ng + w * 16 + 4 * g);
    float c[16], last, mid; hgrn_cum(lf_, r0, hb, p, dk, tot, c, last, mid);
    {
        unsigned vw[8];
#pragma unroll
        for (int i = 0; i < 16; ++i) {
            const int s = p * 16 + i;
            const float qv = bf2f(qraw[i]), kv = bf2f(kraw[i]);
            const float e1 = fminf(fmaxf(c[i] - mid, -60.f), 60.f);
            QT[s * LDQ + dk] = f2bf(qv * __expf(e1)); QP[s * LDQ + dk] = f2bf(qv * __expf(c[i])); KT[s * LDQ + dk] = f2bf(kv * __expf(-e1));
            const unsigned vb = vraw[i]; if (i & 1) vw[i >> 1] |= vb << 16; else vw[i >> 1] = vb;
        }
        LAS u32x4* vd = (LAS u32x4*)(VT + dk * LDS_ + p * 16); vd[0] = (u32x4){vw[0], vw[1], vw[2], vw[3]}; vd[1] = (u32x4){vw[4], vw[5], vw[6], vw[7]};
    }
    __syncthreads();
    {
        const int tt = w >> 1;
#pragma unroll
        for (int q = 0; q < 2; ++q) {
            const int st_ = 2 * (w & 1) + q; u32x2 wv = (u32x2){0u, 0u};
            if (st_ <= tt) {
                f32x4 d = (f32x4){0.f, 0.f, 0.f, 0.f};
#pragma unroll
                for (int ks = 0; ks < 4; ++ks) d = MFMA16(*(const LAS bf16x8*)(KT + (st_ * 16 + c16) * LDQ + ks * 32 + g * 8), *(const LAS bf16x8*)(QT + (tt * 16 + c16) * LDQ + ks * 32 + g * 8), d);
                const int t = tt * 16 + c16, s0 = st_ * 16 + 4 * g;
#pragma unroll
                for (int j = 0; j < 4; ++j) d[j] = (s0 + j <= t) ? d[j] : 0.f;
                wv.x = cvt_pk_bf16(d[0], d[1]); wv.y = cvt_pk_bf16(d[2], d[3]);
            }
            *(LAS u32x2*)(PM + (tt * 16 + c16) * LDS_ + st_ * 16 + 4 * g) = wv;
        }
    }
    __syncthreads();
    f32x4 o[4];
    {
        bf16x8 va[2];
#pragma unroll
        for (int ks = 0; ks < 2; ++ks) va[ks] = *(const LAS bf16x8*)(VT + (w * 16 + c16) * LDS_ + ks * 32 + g * 8);
#pragma unroll
        for (int tt = 0; tt < 4; ++tt) {
            f32x4 d = (f32x4){0.f, 0.f, 0.f, 0.f};
#pragma unroll
            for (int ks = 0; ks < 2; ++ks) if (ks <= (tt >> 1)) d = MFMA16(va[ks], *(const LAS bf16x8*)(PM + (tt * 16 + c16) * LDS_ + ks * 32 + g * 8), d);
#pragma unroll
            for (int ks = 0; ks < 4; ++ks) d = MFMA16(sa[ks], *(const LAS bf16x8*)(QP + (tt * 16 + c16) * LDQ + ks * 32 + g * 8), d);
            o[tt] = d;
            float ss = (d[0] * d[0] + d[1] * d[1]) + (d[2] * d[2] + d[3] * d[3]);
            ss += __shfl_xor(ss, 16); ss += __shfl_xor(ss, 32);
            if (g == 0) red[(tt * 16 + c16) * 8 + w] = ss;
        }
    }
    __syncthreads();
    {
        const int dv0 = w * 16 + 4 * g;
#pragma unroll
        for (int tt = 0; tt < 4; ++tt) {
            const int t = tt * 16 + c16; const f32x4 ra = *(const LAS f32x4*)(red + t * 8), rb = *(const LAS f32x4*)(red + t * 8 + 4);
            const float ssum = ((ra[0] + ra[1]) + (ra[2] + ra[3])) + ((rb[0] + rb[1]) + (rb[2] + rb[3]));
            const float rstd = rsqrtf(ssum * (1.f / 128.f) + LN_EPS);
            const size_t oy = (size_t)(r0 + t) * 1536 + hb + dv0; const u32x2 gw = gwv[tt];
            u32x2 wv; wv.x = cvt_pk_bf16(o[tt][0] * rstd * gn[0] * bflo(gw.x), o[tt][1] * rstd * gn[1] * bfhi(gw.x));
            wv.y = cvt_pk_bf16(o[tt][2] * rstd * gn[2] * bflo(gw.y), o[tt][3] * rstd * gn[3] * bfhi(gw.y));
            *(u32x2*)(yb_ + oy) = wv;
        }
    }
}

#define XB_TMO      128
#define XB_XCNT(j)  (256  + 64 * (j))
#define XB_XSUB(j)  (1280 + 64 * (j))
#define XB_XGEN(j)  (2304 + 64 * (j))
#define XB_TOP      3328
#define XB_TOPGEN   3392
#define XCD_BAR_WORDS 3456
#define XB_SPIN_CAP (1u << 22)
__device__ __forceinline__ unsigned xb_ld(unsigned* p)              { return __hip_atomic_load(p, __ATOMIC_RELAXED, __HIP_MEMORY_SCOPE_AGENT); }
__device__ __forceinline__ unsigned xb_add(unsigned* p, unsigned v) { return __hip_atomic_fetch_add(p, v, __ATOMIC_RELAXED, __HIP_MEMORY_SCOPE_AGENT); }
__device__ __forceinline__ unsigned xb_xcc_id() { return (unsigned)__builtin_amdgcn_s_getreg((3 << 11) | 20) & 0xFu; }
#define XB_SPIN(cond, bar) do { unsigned _sp = 0; while (cond) { __builtin_amdgcn_s_sleep(1); \
    if ((++_sp & 255u) == 0u) { if (xb_ld(&(bar)[XB_TMO])) break; if (_sp > XB_SPIN_CAP) { atomicAdd(&(bar)[XB_TMO], 1u); break; } } } } while (0)
struct XcdBarrier { unsigned* bar; unsigned x; volatile LAS unsigned* st; };
__device__ __forceinline__ XcdBarrier xcd_barrier_post(unsigned* bar, volatile LAS unsigned* st) {
    XcdBarrier b; b.bar = bar; b.x = xb_xcc_id(); b.st = st;
    if (threadIdx.x == 0) (void)xb_add(&bar[XB_XCNT(b.x)], 1u);
    return b;
}
__device__ __forceinline__ void xcd_barrier_complete(unsigned* bar, unsigned x, unsigned& nloc, unsigned& nx) {
    const unsigned G = gridDim.x * gridDim.y * gridDim.z;
    unsigned sum, cnt, mine, sp = 0u;
    for (;;) {
        sum = 0u; cnt = 0u; mine = 0u;
#pragma unroll
        for (unsigned j = 0; j < 16; ++j) { const unsigned c = xb_ld(&bar[XB_XCNT(j)]); sum += c; cnt += (c > 0u) ? 1u : 0u; mine = (j == x) ? c : mine; }
        if (sum == G) break;
        __builtin_amdgcn_s_sleep(1);
        if ((++sp & 255u) == 0u) { if (xb_ld(&bar[XB_TMO])) break; if (sp > XB_SPIN_CAP) { atomicAdd(&bar[XB_TMO], 1u); break; } }
    }
    nloc = mine > 0u ? mine : 1u; nx = cnt > 0u ? cnt : 1u;
}
__device__ __forceinline__ void xcd_barrier(const XcdBarrier& b) {
    asm volatile("s_waitcnt vmcnt(0)" ::: "memory");
    __syncthreads();
    if (threadIdx.x == 0) {
        unsigned* bar = b.bar;
        __builtin_amdgcn_s_waitcnt(0);
        unsigned nloc = b.st[0], nx = b.st[1];
        if (nloc == 0u) { xcd_barrier_complete(bar, b.x, nloc, nx); b.st[0] = nloc; b.st[1] = nx; }
        const unsigned old = xb_add(&bar[XB_XSUB(b.x)], 1u);
        const unsigned gen = old / nloc;
        if (old + 1u == (gen + 1u) * nloc) {
            __builtin_amdgcn_fence(__ATOMIC_RELEASE, "agent");
            asm volatile("s_waitcnt vmcnt(0)" ::: "memory");
            const unsigned og = xb_add(&bar[XB_TOP], 1u);
            const unsigned tg = og / nx;
            if (og + 1u == (tg + 1u) * nx) xb_add(&bar[XB_TOPGEN], 1u);
            else XB_SPIN(xb_ld(&bar[XB_TOPGEN]) == tg, bar);
            __builtin_amdgcn_fence(__ATOMIC_ACQUIRE, "agent");
            xb_add(&bar[XB_XGEN(b.x)], 1u);
            asm volatile("s_waitcnt vmcnt(0)" ::: "memory");
        } else {
            XB_SPIN(xb_ld(&bar[XB_XGEN(b.x)]) == gen, bar);
            __builtin_amdgcn_fence(__ATOMIC_ACQUIRE, "agent");
            asm volatile("s_waitcnt vmcnt(0)" ::: "memory");
        }
    }
    __syncthreads();
}

constexpr int NPH_GROUP = 11, NPH = 1 + 4 * NPH_GROUP;
__global__ __launch_bounds__(512, 2) void mega(Params p) {
    extern __shared__ __attribute__((aligned(16))) unsigned char shm[];
    LAS unsigned char* lds = (LAS unsigned char*)shm;
    cg::grid_group grid = cg::this_grid();
    volatile LAS unsigned* xst = (volatile LAS unsigned*)(lds + 160 * 1024 - 16);
    if (threadIdx.x == 0) { xst[0] = 0u; xst[1] = 0u; }
    __syncthreads();
    XcdBarrier xb = xcd_barrier_post((unsigned*)(p.ws + OFF_BAR), xst);
    if (p.pad == 0x7fffffff) grid.sync();
    unsigned char* const ws0 = p.ws;
    int ph = 0;
#define RUN() (ph >= p.lo && ph < p.hi)
#define NEXT() do { ++ph; if (p.coop && ph > p.lo && ph < p.hi) xcd_barrier(xb); } while (0)
    GroupCtx gcS; gcS.sample = 1; gcS.Tg = DB * DS; gcS.gbaseT = 0; gcS.nbat = DB; gcS.Lk = LCAT; gcS.ab = ws0 + SAR; gcS.sh = 5; gcS.kb = ws0 + S_KB; gcS.vb = ws0 + S_VB; gcS.kib = ws0 + S_KIB; gcS.rev = 1;
    if (RUN()) { phase_weights(p, 0, lds); phase_weights(p, 1, lds); phase_xb(p.x_prompt, (bf16_t*)(p.ws + OFF_XB2), TGMAX); phase_xb(p.x_sample, (bf16_t*)AX(gcS, A_XB), DB * DS); phase_cache(p, 0); }
    NEXT();
    for (int l = 0; l < 2; ++l) {
        for (int gi = 0; gi < 2; ++gi) {
            for (int k = 1; k <= 11; ++k) {
                for (int sub = 0; sub < 2; ++sub) {
                    int ll = l, st = k; GroupCtx gc;
                    if (sub == 0) { gc.sample = 0; gc.Tg = TGMAX; gc.gbaseT = gi * TGMAX; gc.nbat = 2; gc.Lk = SEQ; gc.ab = ws0 + AR; gc.sh = 0; gc.kb = ws0 + A_KB; gc.vb = ws0 + A_VB; gc.kib = ws0 + A_KIB; gc.rev = 0; }
                    else {
                        gc = gcS; st = 0;
                        if (gi == 0) { if (k == 1 && l >= 1) { ll = l - 1; st = 10; } else if (k == 2 && l >= 1) { ll = l - 1; st = 11; } else if ((k == 3 && l >= 1) || (k == 1 && l == 0)) st = 1; else if (k == 4) st = 2; else if (k == 8) st = 5; }
                        else { if (k == 1) st = 6; else if (k == 2) st = 7; else if (k == 8) st = 8; else if (k == 9) st = 9; else if (k == 10 && l == 1) st = 10; else if (k == 11 && l == 1) st = 11; }
                        if (st == 0) continue;
                    }
                    if (!RUN()) continue;
                    __syncthreads();
                    const int Tg = gc.Tg; const int cwg = gc.rev ? (int)gridDim.x - 1 - (int)blockIdx.x : (int)blockIdx.x;
                    unsigned char* ws = sgpr_opaque(ws0);
                    float* yreg = p.out + (gc.sample ? O_YS : O_YP + (size_t)gc.gbaseT * D);
                    const float* xin = (ll == 0) ? (gc.sample ? p.x_sample : p.x_prompt + (size_t)gc.gbaseT * D) : yreg;
                    switch (st) {
                    case 1: {
                        Epi1 E; E.ws = ws; E.out = p.out; E.lbl = p.lb_logits; E.layer = ll; E.gc = gc;
                        Gemm g; g.A = gc.sample ? (const bf16_t*)AX(gc, A_XB) : (const bf16_t*)(ws + OFF_XB2); g.Bt = (const bf16_t*)(ws + (size_t)ll * WL + W_IN); g.K = 1024; g.zA = 0; g.zB = 0;
                        TileOrder S; S.init(Tg, NP1, gridDim.x, cwg, 1);
                        gemm_phase(lds, g, S, E);
                    } break;
                    case 2: {
                        AttnArgs a; a.ws = ws; a.gc = gc;
                        const int nitem = Tg / 8, G = gridDim.x;
                        if (G == 256 && !gc.sample) {
                            const int xcd = (int)blockIdx.x & 7, bl = xcd >> 2, wq = ((int)blockIdx.x >> 3) * 4 + (xcd & 3);
                            for (int r = 0; r < 8; ++r) { const int i = r * 128 + ((r & 1) ? (127 - wq) : wq); attn_item(a, (i >> 3) * 16 + bl * 8 + (i & 7), lds); }
                        } else if (G == 256 && gc.sample) {
                            if ((int)blockIdx.x < nitem) attn_item(a, ((int)blockIdx.x & 7) * 8 + ((int)blockIdx.x >> 3), lds);
                        } else
                        for (int r = 0; r * G < nitem; ++r) { const int it = r * G + ((r & 1) ? (G - 1 - (int)blockIdx.x) : (int)blockIdx.x); if (it < nitem) attn_item(a, it, lds); }
                        HgrnArgs h; h.ws = ws; h.ng = p.norm_g + (size_t)ll * 128; h.gc = gc;
                        const int nh = gc.sample ? DB * 4 : 2 * 4 * 128;
                        if (gc.sample) {
                            for (int it = cwg; it < nh; it += gridDim.x) { hgrn_pass1(h, it, lds); __syncthreads(); hgrn_scan(p, ll, gc, (bf16_t*)AX(gc, A_ST), (const float*)AX(gc, A_DEC), gi, it); hgrn_pass3(h, it, lds); }
                            phase_sconv(p, ll, gc, (const bf16_t*)AX(gc, A_CB), (const bf16_t*)AX(gc, A_U), (bf16_t*)AX(gc, A_YA) + 1024);
                        } else
                        for (int it = blockIdx.x; it < nh; it += gridDim.x) hgrn_pass1(h, it, lds);
                    } break;
                    case 3: {
                        hgrn_scan(p, ll, gc, (bf16_t*)AX(gc, A_ST), (const float*)AX(gc, A_DEC), gi, -1);
                    } break;
                    case 4: {
                        HgrnArgs h; h.ws = ws; h.ng = p.norm_g + (size_t)ll * 128; h.gc = gc;
                        const int nh = 2 * 4 * 128;
                        for (int it = blockIdx.x; it < nh; it += gridDim.x) hgrn_pass3(h, it, lds);
                        phase_sconv(p, ll, gc, (const bf16_t*)AX(gc, A_CB), (const bf16_t*)AX(gc, A_U), (bf16_t*)AX(gc, A_YA) + 1024);
                    } break;
                    case 5: {
                        EpiMerge E; E.gates = (const bf16_t*)AX(gc, A_GATES); E.merged = (bf16_t*)AX(gc, A_MERGED);
                        Gemm g; g.A = (const bf16_t*)AX(gc, A_YA); g.Bt = (const bf16_t*)(ws + (size_t)ll * WL + W_BR); g.K = 1536; g.zA = 0; g.zB = 0;
                        TileOrder S; S.init(Tg, 1024, gridDim.x, cwg, 1);
                        gemm_phase(lds, g, S, E);
                    } break;
                    case 6: {
                        EpiRes E; E.res = xin; E.dst = (float*)AX(gc, A_X1);
                        Gemm g; g.A = (const bf16_t*)AX(gc, A_MERGED); g.Bt = (const bf16_t*)(ws + (size_t)ll * WL + W_OUT); g.K = 1024; g.zA = 0; g.zB = 0;
                        TileOrder S; S.init(Tg, 1024, gridDim.x, cwg, 1);
                        gemm_phase(lds, g, S, E);
                    } break;
                    case 7: {
                        phase_ln((float*)AX(gc, A_X1), (bf16_t*)AX(gc, A_X1B), p.ln1_g + (size_t)ll * D, p.ln1_b + (size_t)ll * D, Tg);
                    } break;
                    case 8: {
                        EpiUpConv E; E.gout = (bf16_t*)AX(gc, A_G); E.halo = (float*)AX(gc, A_H); E.outff = p.out + (gc.sample ? O_FFS + (size_t)ll * DB * 2 * NUP : O_FFP + (size_t)ll * NB * 2 * NUP);
                        E.cw = p.ffn_cw + (size_t)ll * 3 * NUP; E.cbias = p.ffn_cb + (size_t)ll * NUP; E.gc = gc;
                        Gemm g; g.A = (const bf16_t*)AX(gc, A_X1B); g.Bt = (const bf16_t*)(ws + (size_t)ll * WL + W_UP); g.K = 1024; g.zA = 0; g.zB = 0;
                        TileOrder S; S.init(Tg, NUP, gridDim.x, cwg, 1);
                        gemm_phase(lds, g, S, E);
                        if (!gc.sample && gridDim.x == 256) {
                            const int nl = (gi == 1) ? ll + 1 : ll, ng = (gi == 1) ? 0 : 1, lo = 128, hi = (gi == 0) ? 248 : 212;
                            if (nl < 2 && (int)blockIdx.x >= lo && (int)blockIdx.x < hi) { const size_t nbase = (size_t)ng * TGMAX * D;
                                phase_xb((nl == 0) ? p.x_prompt + nbase : p.out + O_YP + nbase, (bf16_t*)(ws + OFF_XB2), TGMAX, (int)blockIdx.x - lo, hi - lo); }
                        }
                    } break;
                    case 9: {
                        phase_ffnfix(p, ll, gc, (const float*)AX(gc, A_H), (bf16_t*)AX(gc, A_G));
                    } break;
                    case 10: {
                        EpiRes E; E.res = (const float*)AX(gc, A_X1); E.dst = yreg;
                        Gemm g; g.A = (const bf16_t*)AX(gc, A_G); g.Bt = (const bf16_t*)(ws + (size_t)ll * WL + W_DN); g.K = DFF; g.zA = 0; g.zB = 0;
                        TileOrder S; S.init(Tg, 1024, gridDim.x, cwg, 1);
                        gemm_phase(lds, g, S, E);
                    } break;
                    default: {
                        phase_ln(yreg, (gc.sample && ll + 1 < 2) ? (bf16_t*)AX(gc, A_XB) : nullptr, p.ln2_g + (size_t)ll * D, p.ln2_b + (size_t)ll * D, Tg);
                        if (gc.sample) { if (ll + 1 < 2) phase_cache(p, ll + 1); }
                        else if (gridDim.x != 256) {
                            const int nl = (gi == 1) ? ll + 1 : ll, ng = (gi == 1) ? 0 : 1;
                            if (nl < 2) { const size_t nbase = (size_t)ng * TGMAX * D; phase_xb((nl == 0) ? p.x_prompt + nbase : p.out + O_YP + nbase, (bf16_t*)(ws + OFF_XB2), TGMAX); }
                        }
                    } break;
                    }
                }
                NEXT();
            }
        }
    }
}

constexpr size_t kDynLds = 160 * 1024;
extern "C" void kernel_launch(void* const* d_in, const int* in_sizes, int n_in, void* d_out, int out_size, void* d_ws, size_t ws_size, hipStream_t stream) {
    Params p{};
    const float** f = (const float**)&p;
    for (int i = 0; i < 23; ++i) f[i] = (const float*)d_in[i];
    p.out = (float*)d_out; p.ws = (unsigned char*)d_ws; p.pad = 0;
    static int inited = 0, grid_blocks = 0;
    if (!inited) {
        hipFuncSetAttribute((const void*)mega, hipFuncAttributeMaxDynamicSharedMemorySize, (int)kDynLds);
        int dev = 0, cus = 0, per_cu = 0; hipGetDevice(&dev); hipDeviceGetAttribute(&cus, hipDeviceAttributeMultiprocessorCount, dev);
        hipOccupancyMaxActiveBlocksPerMultiprocessor(&per_cu, mega, 512, kDynLds);
        if (per_cu < 1) per_cu = 1; grid_blocks = cus * 1; inited = 1;
    }
#ifdef MULTI_LAUNCH
    for (int ph = 0; ph < DBG_NPH; ++ph) { p.lo = ph; p.hi = ph + 1; p.coop = 0; hipLaunchKernelGGL(mega, dim3(grid_blocks), dim3(512), kDynLds, stream, p); }
#else
    p.lo = 0; p.hi = NPH; p.coop = 1;
    (void)hipMemsetAsync((unsigned char*)d_ws + OFF_BAR, 0, XCD_BAR_WORDS * sizeof(unsigned), stream);
    void* args[] = {&p};
    hipError_t e = hipLaunchCooperativeKernel((const void*)mega, dim3(grid_blocks), dim3(512), args, kDynLds, stream);
    if (e != hipSuccess) fprintf(stderr, "cooperative launch failed: %s (grid %d)\n", hipGetErrorString(e), grid_blocks);
#endif
}
```
